# Optimizing an MI355X kernel written in HIP

```python
import math
import jax, jax.numpy as jnp
from jax import lax
import numpy as np

D_MODEL = 1024
BATCH = 2
SEQ = 8192
DEPTH = 1
DEC_BATCH = 4
DEC_SEQ = 8192
PAST_LEN = 128

D_MIX = D_MODEL
A_HEADS = 4
A_DIM = 64
A_VDIM = 2 * A_DIM
B_HEADS = 8
B_KV_HEADS = 2
B_DIM = 64
B_GROUP = B_HEADS // B_KV_HEADS
A_Q_COLS = A_HEADS * 2 * A_DIM
A_K_COLS = A_HEADS * 2 * A_DIM
A_V_COLS = A_HEADS * A_VDIM
B_Q_COLS = B_HEADS * B_DIM
B_KV_COLS = B_KV_HEADS * B_DIM
OFF_AK = A_Q_COLS
OFF_AV = OFF_AK + A_K_COLS
OFF_BQ = OFF_AV + A_V_COLS
OFF_BK = OFF_BQ + B_Q_COLS
OFF_BV = OFF_BK + B_KV_COLS
IN_COLS = OFF_BV + B_KV_COLS
A_OUT = A_HEADS * A_VDIM
B_OUT = B_HEADS * B_DIM
ROPE_THETA = 10000.0
GRID_W = 64
Q_BLOCK = 128
NORM_EPS = 1e-6
PEER_HEADS = 8
PEER_N_KEYS = 128
PEER_N_EXPERTS = PEER_N_KEYS * PEER_N_KEYS
PEER_D_QUERY = 256
PEER_D_HALF = PEER_D_QUERY // 2
PEER_TOPK = 16
PEER_BLOCK = 128

kernel_name = "hymba_diffattn_axialgqa_peer_encoder"


def rms_norm(x, w):
    xf = x.astype(jnp.float32)
    xf = xf * lax.rsqrt(jnp.mean(xf * xf, axis=-1, keepdims=True) + NORM_EPS)
    return (xf * w.astype(jnp.float32)).astype(x.dtype)


def rope_tables(pos, dim):
    inv = ROPE_THETA ** (-jnp.arange(0, dim, 2, dtype=jnp.float32) / dim)
    ang = pos[:, None] * inv[None, :]
    ang = jnp.concatenate([ang, ang], axis=-1)
    return jnp.cos(ang), jnp.sin(ang)


def apply_rope(x, cos, sin):
    half = x.shape[-1] // 2
    xf = x.astype(jnp.float32)
    rot = jnp.concatenate([-xf[..., half:], xf[..., :half]], axis=-1)
    return (xf * cos[None, :, None, :] + rot * sin[None, :, None, :]).astype(x.dtype)


def apply_axial_rope(x, cos_r, sin_r, cos_c, sin_c):
    half = x.shape[-1] // 2
    return jnp.concatenate([apply_rope(x[..., :half], cos_r, sin_r),
                            apply_rope(x[..., half:], cos_c, sin_c)], axis=-1)


def to_qblocks(t):
    b, s = t.shape[:2]
    return jnp.moveaxis(t.reshape(b, s // Q_BLOCK, Q_BLOCK, *t.shape[2:]), 1, 0)


def from_qblocks(o):
    nb, b, q = o.shape[:3]
    return jnp.moveaxis(o, 0, 1).reshape(b, nb * q, *o.shape[3:])


def diff_attention(q1, q2, k1, k2, v, lam):
    scale = A_DIM ** -0.5

    def block(qs):
        qb1, qb2 = qs
        a1 = jax.nn.softmax(jnp.einsum('bqhd,bkhd->bhqk', qb1, k1).astype(jnp.float32) * scale, axis=-1)
        a2 = jax.nn.softmax(jnp.einsum('bqhd,bkhd->bhqk', qb2, k2).astype(jnp.float32) * scale, axis=-1)
        attn = (a1 - lam * a2).astype(v.dtype)
        return jnp.einsum('bhqk,bkhe->bqhe', attn, v)

    return from_qblocks(lax.map(block, (to_qblocks(q1), to_qblocks(q2))))


def gqa_attention(q, k, v):
    b, s = q.shape[:2]
    scale = B_DIM ** -0.5
    qg = q.reshape(b, s, B_KV_HEADS, B_GROUP, B_DIM)

    def block(qb):
        p = jax.nn.softmax(jnp.einsum('bqgrd,bkgd->bgrqk', qb, k).astype(jnp.float32) * scale, axis=-1)
        return jnp.einsum('bgrqk,bkgd->bqgrd', p.astype(v.dtype), v)

    out = from_qblocks(lax.map(block, to_qblocks(qg)))
    return out.reshape(b, s, B_OUT)


def peer_ffn(xn, wq, keys, u, v):
    b, s, d = xn.shape
    xt = xn.reshape((b * s) // PEER_BLOCK, PEER_BLOCK, d)

    def block(xb):
        q = (xb @ wq).reshape(PEER_BLOCK, PEER_HEADS, 2, PEER_D_HALF)
        sc = jnp.einsum('thcd,hcnd->thcn', q, keys).astype(jnp.float32)
        s1, i1 = lax.top_k(sc[:, :, 0], PEER_TOPK)
        s2, i2 = lax.top_k(sc[:, :, 1], PEER_TOPK)
        cand_s = (s1[..., :, None] + s2[..., None, :]).reshape(PEER_BLOCK, PEER_HEADS, PEER_TOPK * PEER_TOPK)
        cand_i = (i1[..., :, None] * PEER_N_KEYS + i2[..., None, :]).reshape(PEER_BLOCK, PEER_HEADS, PEER_TOPK * PEER_TOPK)
        top_s, pos = lax.top_k(cand_s, PEER_TOPK)
        idx = jnp.take_along_axis(cand_i, pos, axis=-1)
        g = jax.nn.softmax(top_s, axis=-1)
        act = jax.nn.gelu(jnp.einsum('thkd,td->thk', u[idx], xb).astype(jnp.float32), approximate=False)
        w = (g * act).astype(xb.dtype)
        return jnp.einsum('thk,thkd->td', w, v[idx])

    return lax.map(block, xt).reshape(b, s, d)


def encoder_layer(x, layer_idx, tables, attn_norm, w_in, lambda_q1, lambda_k1, lambda_q2, lambda_k2,
                  subln_w, q_norm_w, k_norm_w, w_out, ffn_norm, peer_wq, peer_keys, peer_u, peer_v):
    cos_a, sin_a, cos_r, sin_r, cos_c, sin_c = tables
    b, s, _ = x.shape
    lambda_init = 0.8 - 0.6 * math.exp(-0.3 * (layer_idx + 1))

    h = rms_norm(x, attn_norm)
    proj = h @ w_in
    qa = proj[..., :OFF_AK].reshape(b, s, A_HEADS, 2, A_DIM)
    ka = proj[..., OFF_AK:OFF_AV].reshape(b, s, A_HEADS, 2, A_DIM)
    va = proj[..., OFF_AV:OFF_BQ].reshape(b, s, A_HEADS, A_VDIM)
    qa1 = apply_rope(qa[..., 0, :], cos_a, sin_a)
    qa2 = apply_rope(qa[..., 1, :], cos_a, sin_a)
    ka1 = apply_rope(ka[..., 0, :], cos_a, sin_a)
    ka2 = apply_rope(ka[..., 1, :], cos_a, sin_a)
    lam = (jnp.exp(jnp.sum(lambda_q1.astype(jnp.float32) * lambda_k1.astype(jnp.float32)))
           - jnp.exp(jnp.sum(lambda_q2.astype(jnp.float32) * lambda_k2.astype(jnp.float32)))
           + lambda_init)
    out_a = diff_attention(qa1, qa2, ka1, ka2, va, lam)
    out_a = (rms_norm(out_a, subln_w) * (1.0 - lambda_init)).reshape(b, s, A_OUT)
    qb = proj[..., OFF_BQ:OFF_BK].reshape(b, s, B_HEADS, B_DIM)
    kb = proj[..., OFF_BK:OFF_BV].reshape(b, s, B_KV_HEADS, B_DIM)
    vb = proj[..., OFF_BV:].reshape(b, s, B_KV_HEADS, B_DIM)
    qb = apply_axial_rope(rms_norm(qb, q_norm_w), cos_r, sin_r, cos_c, sin_c)
    kb = apply_axial_rope(rms_norm(kb, k_norm_w), cos_r, sin_r, cos_c, sin_c)
    out_b = gqa_attention(qb, kb, vb)
    x = x + jnp.concatenate([out_a, out_b], axis=-1) @ w_out
    x = x + peer_ffn(rms_norm(x, ffn_norm), peer_wq, peer_keys, peer_u, peer_v)
    return x


def encoder_forward(x, attn_norm, w_in, lambda_q1, lambda_k1, lambda_q2, lambda_k2, subln_w,
                    q_norm_w, k_norm_w, w_out, ffn_norm, peer_wq, peer_keys, peer_u, peer_v, final_norm):
    s = x.shape[1]
    rows = s // GRID_W
    t = jnp.arange(s, dtype=jnp.float32)
    row = jnp.broadcast_to(jnp.arange(rows, dtype=jnp.float32)[:, None], (rows, GRID_W)).reshape(s)
    col = jnp.broadcast_to(jnp.arange(GRID_W, dtype=jnp.float32)[None, :], (rows, GRID_W)).reshape(s)
    cos_a, sin_a = rope_tables(t, A_DIM)
    cos_r, sin_r = rope_tables(row, B_DIM // 2)
    cos_c, sin_c = rope_tables(col, B_DIM // 2)
    tables = (cos_a, sin_a, cos_r, sin_r, cos_c, sin_c)
    for i in range(DEPTH):
        x = encoder_layer(x, i, tables, attn_norm[i], w_in[i], lambda_q1[i], lambda_k1[i], lambda_q2[i],
                          lambda_k2[i], subln_w[i], q_norm_w[i], k_norm_w[i], w_out[i], ffn_norm[i],
                          peer_wq[i], peer_keys[i], peer_u[i], peer_v[i])
    return rms_norm(x, final_norm)


def setup_inputs(seed: int = 0) -> dict:
    key = jax.random.key(seed)
    ks = jax.random.split(key, 19)
    f32 = jnp.float32

    def nrm(k, shape, scale):
        return jax.random.normal(k, shape, dtype=f32) * scale

    def gain(k, shape):
        return 1.0 + 0.01 * jax.random.normal(k, shape, dtype=f32)

    return {
        "x_prompt": nrm(ks[0], (BATCH, SEQ, D_MODEL), 1.0),
        "x_sample": nrm(ks[1], (DEC_BATCH, DEC_SEQ, D_MODEL), 1.0),
        "attn_norm": gain(ks[2], (DEPTH, D_MODEL)),
        "w_in": nrm(ks[3], (DEPTH, D_MODEL, IN_COLS), D_MODEL ** -0.5),
        "lambda_q1": nrm(ks[4], (DEPTH, A_DIM), 0.1),
        "lambda_k1": nrm(ks[5], (DEPTH, A_DIM), 0.1),
        "lambda_q2": nrm(ks[6], (DEPTH, A_DIM), 0.1),
        "lambda_k2": nrm(ks[7], (DEPTH, A_DIM), 0.1),
        "subln_w": gain(ks[8], (DEPTH, A_VDIM)),
        "q_norm_w": gain(ks[9], (DEPTH, B_DIM)),
        "k_norm_w": gain(ks[10], (DEPTH, B_DIM)),
        "w_out": nrm(ks[11], (DEPTH, D_MIX, D_MODEL), D_MIX ** -0.5),
        "ffn_norm": gain(ks[12], (DEPTH, D_MODEL)),
        "peer_wq": nrm(ks[13], (DEPTH, D_MODEL, PEER_HEADS * PEER_D_QUERY), D_MODEL ** -0.5),
        "peer_keys": nrm(ks[14], (DEPTH, PEER_HEADS, 2, PEER_N_KEYS, PEER_D_HALF), PEER_D_HALF ** -0.5),
        "peer_u": nrm(ks[15], (DEPTH, PEER_N_EXPERTS, D_MODEL), D_MODEL ** -0.5),
        "peer_v": nrm(ks[16], (DEPTH, PEER_N_EXPERTS, D_MODEL), (PEER_HEADS * PEER_TOPK) ** -0.5),
        "final_norm": gain(ks[17], (D_MODEL,)),
    }


def reference(x_prompt, x_sample, attn_norm, w_in, lambda_q1, lambda_k1, lambda_q2, lambda_k2, subln_w,
              q_norm_w, k_norm_w, w_out, ffn_norm, peer_wq, peer_keys, peer_u, peer_v, final_norm):
    y_prompt = encoder_forward(x_prompt, attn_norm, w_in, lambda_q1, lambda_k1, lambda_q2, lambda_k2, subln_w,
                               q_norm_w, k_norm_w, w_out, ffn_norm, peer_wq, peer_keys, peer_u, peer_v, final_norm)
    y_sample = encoder_forward(x_sample, attn_norm, w_in, lambda_q1, lambda_k1, lambda_q2, lambda_k2, subln_w,
                               q_norm_w, k_norm_w, w_out, ffn_norm, peer_wq, peer_keys, peer_u, peer_v, final_norm)
    return (y_prompt, y_sample)
```

```cpp
#define PEER_NB 2
#define PEER_NBU 2
#include <hip/hip_runtime.h>
#include <hip/hip_bf16.h>
#include <hip/hip_cooperative_groups.h>
#include <cstdio>
#include <cstdint>
#include <math.h>
namespace cg = cooperative_groups;

constexpr int D = 1024, M = 49152, MP = 16384, SEQ = 8192, NCOL = 2304, NSEQ = 6;
constexpr float EPS = 1e-6f;
constexpr float LAMBDA_INIT = 0.35550906759f;
constexpr float C2 = 0.125f * 1.4426950408889634f;
constexpr int NEXP = 16384;

constexpr size_t MiB = 1u << 20;
constexpr size_t WS_WIN = 0, WS_WOUT = 5 * MiB, WS_WK = 8 * MiB, WS_ROPEA = 12 * MiB, WS_ROPER = 14 * MiB, WS_ROPEC = 14 * MiB + 65536, WS_CTL = 15 * MiB, WS_BAR = 15 * MiB + 65536;
constexpr size_t WS_U16 = 16 * MiB, WS_V16 = 48 * MiB, WS_XN = 80 * MiB  ;
constexpr size_t WS_QA = 176 * MiB, WS_KA = 224 * MiB, WS_VA = 272 * MiB, WS_QB = 320 * MiB, WS_KB = 368 * MiB, WS_VB = 380 * MiB;
constexpr size_t WS_X1B = 176 * MiB  ;
constexpr size_t WS_TKI = 392 * MiB, WS_TKS = 416 * MiB, WS_WG = 440 * MiB, WS_END = 464 * MiB;

__device__ __forceinline__ const float* xrow(const float* xp, const float* xs, int m) { return m < MP ? xp + (size_t)m * D : xs + (size_t)(m - MP) * D; }
template <int CTRL> __device__ __forceinline__ float dppf(float v) { return __uint_as_float((unsigned)__builtin_amdgcn_update_dpp(0, (int)__float_as_uint(v), CTRL, 0xF, 0xF, true)); }
__device__ __forceinline__ float swap_add32(float a, float b) { auto r = __builtin_amdgcn_permlane32_swap(__float_as_uint(a), __float_as_uint(b), false, false); return __uint_as_float(r[0]) + __uint_as_float(r[1]); }
__device__ __forceinline__ float swap_add16(float a, float b) { auto r = __builtin_amdgcn_permlane16_swap(__float_as_uint(a), __float_as_uint(b), false, false); return __uint_as_float(r[0]) + __uint_as_float(r[1]); }
__device__ __forceinline__ float row16_sum(float v) { v += dppf<0xB1>(v); v += dppf<0x4E>(v); v += dppf<0x141>(v); v += dppf<0x140>(v); return v; }
__device__ __forceinline__ float row16_max(float v) { v = fmaxf(v, dppf<0xB1>(v)); v = fmaxf(v, dppf<0x4E>(v)); v = fmaxf(v, dppf<0x141>(v)); v = fmaxf(v, dppf<0x140>(v)); return v; }
__device__ __forceinline__ float wave_sum(float v) { v = row16_sum(v); v = swap_add16(v, v); return swap_add32(v, v); }
namespace pg8 {
#define PG8_LAS __attribute__((address_space(3)))
typedef unsigned short bf16_t;
typedef short bf16x8 __attribute__((ext_vector_type(8)));
typedef float f32x4 __attribute__((ext_vector_type(4)));
typedef unsigned u32x4 __attribute__((ext_vector_type(4)));
constexpr int BM = 256, BK = 64, HALF = 128, HTB = HALF * BK * 2  , STAGE_BYTES = 8 * HTB, NXCD = 8, WGM = 8;

__host__ __device__ __forceinline__ int lds_byte(int r, int c) { const int st = (r >> 4) * 2 + (c >> 5), rr = r & 15, cc = c & 31, ob = rr * 64 + cc * 2; return st * 1024 + (ob ^ (((ob >> 9) & 1) << 5)); }
__host__ __device__ __forceinline__ void stage_rc(int b, int& R, int& C) { const int st = b / 1024, sb = b % 1024, swz = sb ^ (((sb >> 9) & 1) << 5); R = (st >> 1) * 16 + swz / 64; C = (st & 1) * 32 + (swz % 64) / 2; }
__host__ __device__ __forceinline__ int perm32(int rho) { const int n = rho >> 4, i = rho & 15; return 8 * (i >> 2) + 4 * n + (i & 3); }

struct Unit { int pm, pn; };
struct Gemm { const bf16_t* A; const bf16_t* Bt; int M, N, K; };

struct StaticOrder {
    int nM, nN, nwg, G, c;
    __host__ __device__ void init(int M, int N, int G_, int c_) { nM = M / BM; nN = N / BM; nwg = nM * nN; G = G_; c = c_; }
    __host__ __device__ bool next(int i, Unit& u) const {
        const long L = (long)i * G + c; if (L >= nwg) return false;
        int wgid = (int)L; { const int q = nwg / NXCD, r = nwg % NXCD, xcd = wgid % NXCD, off = wgid / NXCD; wgid = (xcd < r ? xcd * (q + 1) : r * (q + 1) + (xcd - r) * q) + off; }
        const int nig = WGM * nN, gid = wgid / nig, fm = gid * WGM, gsz = (nM - fm) < WGM ? (nM - fm) : WGM;
        u.pm = fm + ((wgid % nig) % gsz); u.pn = (wgid % nig) / gsz; return true;
    }
    __device__ __forceinline__ void a_ready(const Unit&) const {}
    __device__ __forceinline__ void done(const Unit&) const {}
};

__device__ __forceinline__ unsigned cvt_pk_bf16(float lo, float hi) { unsigned r; asm volatile("v_cvt_pk_bf16_f32 %0, %1, %2" : "=v"(r) : "v"(lo), "v"(hi)); return r; }
typedef float f32x2 __attribute__((ext_vector_type(2)));
__device__ __forceinline__ f32x2 gelu_pk(f32x2 v) {
    const f32x2 av = __builtin_elementwise_abs(v), d = av * 0.2316418882f + 1.0f;
    f32x2 t; t.x = __builtin_amdgcn_rcpf(d.x); t.y = __builtin_amdgcn_rcpf(d.y);
    f32x2 q = t * 0.5307027145f + (-0.7265760135f); q = q * t + 0.7107068705f; q = q * t + (-0.142248368f); q = q * t + 0.127414796f; q = q * t;
    const f32x2 s = (v * v) * (-0.72134752044f);
    f32x2 e; e.x = __builtin_amdgcn_exp2f(s.x); e.y = __builtin_amdgcn_exp2f(s.y);
    const f32x2 m = v * (q * e), r = v - m;
    f32x2 o; o.x = v.x < 0.f ? m.x : r.x; o.y = v.y < 0.f ? m.y : r.y; return o;
}

template <int ACT  > struct EpiBf16 {
    static constexpr bool PERM = true, AFTER_DRAIN = false; static_assert(ACT == 0 || ACT == 1, "EpiBf16: ACT is 0 (none) or 1 (gelu_pk)");
    bf16_t* O; int ldc; const float* bias; int split_cols; size_t split_stride; float scale0;
    __device__ __forceinline__ void operator()(const f32x4 (&acc)[2][2][4][2], const Unit& u, int wr, int wc, int fr, int fq) const {
        const int row0 = u.pm * BM + wr * 64 + fr; int colt = u.pn * BM; bf16_t* base = O;
        float sc = 1.f; if (split_cols) { const int t = colt / split_cols; base += (size_t)t * split_stride; colt -= t * split_cols; if (t == 0) sc = scale0; }
        const int col0 = colt + wc * 32 + 8 * fq, bcol0 = u.pn * BM + wc * 32 + 8 * fq;
        f32x4 bv[2][2];
#pragma unroll
        for (int bj = 0; bj < 2; ++bj)
#pragma unroll
            for (int n = 0; n < 2; ++n) bv[bj][n] = bias ? *(const f32x4*)(bias + bcol0 + bj * HALF + 4 * n) : (f32x4){0.f, 0.f, 0.f, 0.f};
#pragma unroll
        for (int ai = 0; ai < 2; ++ai)
#pragma unroll
            for (int m = 0; m < 4; ++m) { bf16_t* rowp = base + (size_t)(row0 + ai * HALF + m * 16) * ldc + col0;
#pragma unroll
                for (int bj = 0; bj < 2; ++bj) { f32x4 v0 = acc[ai][bj][m][0] + bv[bj][0], v1 = acc[ai][bj][m][1] + bv[bj][1];
                    if (ACT == 1) { f32x2 a = gelu_pk((f32x2){v0[0], v0[1]}), b = gelu_pk((f32x2){v0[2], v0[3]}), c = gelu_pk((f32x2){v1[0], v1[1]}), d = gelu_pk((f32x2){v1[2], v1[3]});
                        v0 = (f32x4){a.x, a.y, b.x, b.y}; v1 = (f32x4){c.x, c.y, d.x, d.y}; }
                    v0 = v0 * sc; v1 = v1 * sc; u32x4 w; w.x = cvt_pk_bf16(v0[0], v0[1]); w.y = cvt_pk_bf16(v0[2], v0[3]); w.z = cvt_pk_bf16(v1[0], v1[1]); w.w = cvt_pk_bf16(v1[2], v1[3]);
                    *(u32x4*)(rowp + bj * HALF) = w; } }
    }
};
typedef float f32x2g __attribute__((ext_vector_type(2)));
typedef unsigned u32x2 __attribute__((ext_vector_type(2)));
#ifdef GQA_DEBUG_BUILD
constexpr bool GQA_BF16 = true;
#else
constexpr bool GQA_BF16 = false;
#endif
__host__ __device__ __forceinline__ int win_col_of_slot(int pn, int j) {
    const int bj = j >> 7, wc = (j >> 5) & 3, s = j & 31;
    const int base = 256 * pn + 64 * wc;
    const bool axial = (base >= 1536 && base < 2176);
    return axial ? base + 32 * (s >> 4) + 16 * bj + (s & 15) : base + 32 * bj + s;
}
__host__ __device__ __forceinline__ int win_slot_of_col(int n) {
    const int pn = n >> 8, cw = n & 255, wc = cw >> 6, dd = cw & 63;
    const int base = 256 * pn + 64 * wc;
    const bool axial = (base >= 1536 && base < 2176);
    int bj, s;
    if (axial) { const int r = dd >> 5; bj = (dd >> 4) & 1; s = 16 * r + (dd & 15); } else { bj = dd >> 5; s = dd & 31; }
    return 256 * pn + 128 * bj + 32 * wc + s;
}
struct EpiProj {
    static constexpr bool PERM = true, AFTER_DRAIN = false;
    bf16_t *QA, *KA, *VA, *QB, *KB, *VB;
    const f32x2g *ropeA, *ropeR, *ropeC; const float *qnw, *knw;
    unsigned char *Q8, *K8, *V8T;
    static __device__ __forceinline__ unsigned pk8(float x0, float x1, float x2, float x3) { int w = 0; w = __builtin_amdgcn_cvt_pk_fp8_f32(x0, x1, w, false); w = __builtin_amdgcn_cvt_pk_fp8_f32(x2, x3, w, true); return (unsigned)w; }
    __device__ __forceinline__ void operator()(const f32x4 (&acc)[2][2][4][2], const Unit& u, int wr, int wc, int fr, int fq) const {
        const int pn = u.pn;
        int kind, pitch, chunk; bf16_t* dst;
        if (pn < 2) { kind = 0; dst = QA; pitch = 512; chunk = (pn & 1) * 4 + wc; }
        else if (pn < 4) { kind = 1; dst = KA; pitch = 512; chunk = (pn & 1) * 4 + wc; }
        else if (pn < 6) { kind = 2; dst = VA; pitch = 512; chunk = (pn & 1) * 4 + wc; }
        else if (pn < 8) { kind = 3; dst = QB; pitch = 512; chunk = (pn & 1) * 4 + wc; }
        else if (wc < 2) { kind = 4; dst = KB; pitch = 128; chunk = wc; }
        else { kind = 2; dst = VB; pitch = 128; chunk = wc - 2; }
        const float qs = (kind == 0) ? C2 : (kind == 3 && !GQA_BF16) ? 1.4426950408889634f : (kind == 3) ? C2 : 1.0f;
        float wa[8], wb[8];
        if (kind >= 3) { const float* nw = (kind == 3) ? qnw : knw; const int d0 = 32 * (fq >> 1) + 8 * (fq & 1);
#pragma unroll
            for (int e = 0; e < 8; ++e) { wa[e] = nw[d0 + e]; wb[e] = nw[d0 + 16 + e]; } }
#pragma unroll
        for (int ai = 0; ai < 2; ++ai)
#pragma unroll
            for (int m = 0; m < 4; ++m) {
                const int row = u.pm * BM + ai * HALF + wr * 64 + m * 16 + fr, t = row & (SEQ - 1);
                float a[8], b[8];
#pragma unroll
                for (int e = 0; e < 8; ++e) { a[e] = acc[ai][0][m][e >> 2][e & 3]; b[e] = acc[ai][1][m][e >> 2][e & 3]; }
                if (kind != 2) {
                    const f32x2g* tb;
                    if (kind < 2) tb = ropeA + t * 32 + 8 * fq;
                    else {
                        float ss = 0.f;
#pragma unroll
                        for (int e = 0; e < 8; ++e) ss += a[e] * a[e] + b[e] * b[e];
                        ss += __shfl_xor(ss, 16); ss += __shfl_xor(ss, 32);
                        const float rstd = 1.0f / sqrtf(ss * (1.0f / 64.0f) + EPS);
#pragma unroll
                        for (int e = 0; e < 8; ++e) { a[e] *= rstd * wa[e]; b[e] *= rstd * wb[e]; }
                        tb = ((fq >> 1) == 0 ? ropeR + (t >> 6) * 16 : ropeC + (t & 63) * 16) + 8 * (fq & 1);
                    }
#pragma unroll
                    for (int e = 0; e < 8; ++e) { const f32x2g cs = tb[e]; const float oa = a[e] * cs.x - b[e] * cs.y, ob = b[e] * cs.x + a[e] * cs.y; a[e] = oa * qs; b[e] = ob * qs; }
                }
                if (pn >= 6) {
                    const float f8s = (GQA_BF16 && kind == 3) ? 8.0f : 1.0f;
                    if (kind != 2) {
                        unsigned char* p8 = ((kind == 3) ? Q8 : K8) + ((size_t)chunk * M + row) * 64 + 8 * fq;
                        u32x2 wa8, wb8;
                        wa8.x = pk8(a[0] * f8s, a[1] * f8s, a[2] * f8s, a[3] * f8s); wa8.y = pk8(a[4] * f8s, a[5] * f8s, a[6] * f8s, a[7] * f8s);
                        wb8.x = pk8(b[0] * f8s, b[1] * f8s, b[2] * f8s, b[3] * f8s); wb8.y = pk8(b[4] * f8s, b[5] * f8s, b[6] * f8s, b[7] * f8s);
                        *(u32x2*)p8 = wa8; *(u32x2*)(p8 + 32) = wb8;
                    } else {
                        const int k6 = row & 63;
                        unsigned char* p8 = V8T + (((size_t)chunk * (M / 64) + (row >> 6)) * 64 + 8 * fq) * 64 + 32 * ((k6 >> 2) & 1) + 16 * (k6 >> 5) + 4 * ((k6 >> 3) & 3) + (k6 & 3);
                        const unsigned wa0 = pk8(a[0], a[1], a[2], a[3]), wa1 = pk8(a[4], a[5], a[6], a[7]), wb0 = pk8(b[0], b[1], b[2], b[3]), wb1 = pk8(b[4], b[5], b[6], b[7]);
#pragma unroll
                        for (int e = 0; e < 4; ++e) { p8[e * 64] = (unsigned char)(wa0 >> (8 * e)); p8[(4 + e) * 64] = (unsigned char)(wa1 >> (8 * e));
                                                      p8[(32 + e) * 64] = (unsigned char)(wb0 >> (8 * e)); p8[(36 + e) * 64] = (unsigned char)(wb1 >> (8 * e)); }
                    }
                    if (!GQA_BF16) continue;
                }
                bf16_t* p = dst + (size_t)row * pitch + chunk * 64 + 8 * fq;
                u32x4 w0, w1;
                w0.x = cvt_pk_bf16(a[0], a[1]); w0.y = cvt_pk_bf16(a[2], a[3]); w0.z = cvt_pk_bf16(a[4], a[5]); w0.w = cvt_pk_bf16(a[6], a[7]);
                w1.x = cvt_pk_bf16(b[0], b[1]); w1.y = cvt_pk_bf16(b[2], b[3]); w1.z = cvt_pk_bf16(b[4], b[5]); w1.w = cvt_pk_bf16(b[6], b[7]);
                *(u32x4*)p = w0; *(u32x4*)(p + 32) = w1;
            }
    }
};
struct EpiResid {
    static constexpr bool PERM = true, AFTER_DRAIN = false;
    const float *xp, *xs; float* X1; bf16_t* X1B;
    __device__ __forceinline__ void operator()(const f32x4 (&acc)[2][2][4][2], const Unit& u, int wr, int wc, int fr, int fq) const {
#pragma unroll
        for (int ai = 0; ai < 2; ++ai)
#pragma unroll
            for (int m = 0; m < 4; ++m) {
                const int row = u.pm * BM + ai * HALF + wr * 64 + m * 16 + fr;
                const float* xr = xrow(xp, xs, row);
#pragma unroll
                for (int bj = 0; bj < 2; ++bj) {
                    const int col = u.pn * BM + bj * HALF + wc * 32 + 8 * fq;
                    const f32x4 x0 = *(const f32x4*)(xr + col), x1v = *(const f32x4*)(xr + col + 4);
                    const f32x4 v0 = acc[ai][bj][m][0] + x0, v1 = acc[ai][bj][m][1] + x1v;
                    u32x4 w; w.x = cvt_pk_bf16(v0[0], v0[1]); w.y = cvt_pk_bf16(v0[2], v0[3]); w.z = cvt_pk_bf16(v1[0], v1[1]); w.w = cvt_pk_bf16(v1[2], v1[3]);
                    *(u32x4*)(X1B + (size_t)row * D + col) = w;
                }
            }
    }
};
struct OneUnit { Unit u;
    __host__ __device__ bool next(int i, Unit& o) const { if (i != 0) return false; o = u; return true; }
    __device__ __forceinline__ void a_ready(const Unit&) const {}
    __device__ __forceinline__ void done(const Unit&) const {}
};
__device__ __forceinline__ unsigned f2key(float f) { const unsigned u = __float_as_uint(f); return u ^ ((u >> 31) ? 0xFFFFFFFFu : 0x80000000u); }
__device__ __forceinline__ float key2f(unsigned k) { return __uint_as_float((k & 0x80000000u) ? (k ^ 0x80000000u) : ~k); }
__device__ __forceinline__ unsigned umax_(unsigned a, unsigned b) { return a > b ? a : b; }
__device__ __forceinline__ unsigned umin_(unsigned a, unsigned b) { return a < b ? a : b; }
#define CE(i, j) { const unsigned a_ = k[i], b_ = k[j]; k[i] = umax_(a_, b_); k[j] = umin_(a_, b_); }
__device__ __forceinline__ void sort16_desc(unsigned (&k)[16]) {
    CE(0,1) CE(2,3) CE(0,2) CE(1,3) CE(1,2) CE(4,5) CE(6,7) CE(4,6) CE(5,7) CE(5,6) CE(0,4) CE(2,6) CE(2,4) CE(1,5) CE(3,7) CE(3,5) CE(1,2) CE(3,4) CE(5,6) CE(8,9) CE(10,11) CE(8,10) CE(9,11) CE(9,10) CE(12,13) CE(14,15) CE(12,14) CE(13,15) CE(13,14) CE(8,12) CE(10,14) CE(10,12) CE(9,13) CE(11,15) CE(11,13) CE(9,10) CE(11,12) CE(13,14) CE(0,8) CE(4,12) CE(4,8) CE(2,10) CE(6,14) CE(6,10) CE(2,4) CE(6,8) CE(10,12) CE(1,9) CE(5,13) CE(5,9) CE(3,11) CE(7,15) CE(7,11) CE(3,5) CE(7,9) CE(11,13) CE(1,2) CE(3,4) CE(5,6) CE(7,8) CE(9,10) CE(11,12) CE(13,14)
}
#undef CE
__device__ __forceinline__ void merge16_desc(unsigned (&t)[16], const unsigned (&g)[16]) {
#pragma unroll
    for (int i = 0; i < 16; ++i) t[i] = umax_(t[i], g[15 - i]);
#pragma unroll
    for (int st = 8; st > 0; st >>= 1)
#pragma unroll
        for (int i = 0; i < 16; ++i) { const int l = i ^ st; if (l > i) { const unsigned a = t[i], b = t[l]; t[i] = umax_(a, b); t[l] = umin_(a, b); } }
}
struct EpiTopK {
    static constexpr bool PERM = false, AFTER_DRAIN = true;
    static constexpr int RP = 132, SC_BYTES = 256 * RP * 4, L1_OFF = SC_BYTES;
    int* tki; float* tks;
    __device__ __forceinline__ void fused(f32x4 (&acc)[2][2][4][2], const Unit& u, int wr, int wc, int fr, int fq, PG8_LAS unsigned char* lds, int wid, int lane) const {
        PG8_LAS float* sc = (PG8_LAS float*)lds;
        PG8_LAS unsigned* l1 = (PG8_LAS unsigned*)(lds + L1_OFF);
        const int tid = wid * 64 + lane, h = u.pn;
#pragma unroll
        for (int ai = 0; ai < 2; ++ai) {
#pragma unroll
            for (int m = 0; m < 4; ++m)
#pragma unroll
                for (int bj = 0; bj < 2; ++bj)
#pragma unroll
                    for (int n = 0; n < 2; ++n)
#pragma unroll
                        for (int j = 0; j < 4; ++j) sc[(bj * 128 + wc * 32 + n * 16 + fq * 4 + j) * RP + wr * 64 + m * 16 + fr] = acc[ai][bj][m][n][j];
            __syncthreads();
            {
                const int row = tid & 127, c = (tid >> 7) & 1, hh = tid >> 8;
                unsigned T[16], G[16];
                PG8_LAS const float* scp = sc + (c * 128 + 64 * hh) * RP + row;
                const unsigned tag0 = (unsigned)(127 - 64 * hh);
#pragma unroll
                for (int i = 0; i < 16; ++i) T[i] = (f2key(scp[i * RP]) & ~127u) | (tag0 - (unsigned)i);
                sort16_desc(T);
#pragma unroll 1
                for (int g = 1; g < 4; ++g) {
#pragma unroll
                    for (int i = 0; i < 16; ++i) G[i] = (f2key(scp[(g * 16 + i) * RP]) & ~127u) | (tag0 - (unsigned)(g * 16 + i));
                    sort16_desc(G); merge16_desc(T, G);
                }
                __syncthreads();
                PG8_LAS unsigned* hl = (PG8_LAS unsigned*)lds;
#pragma unroll
                for (int i = 0; i < 16; ++i) hl[(hh * 16 + i) * 256 + c * 128 + row] = T[i];
            }
            __syncthreads();
            if (tid < 256) {
                const int row = tid & 127, c = tid >> 7;
                PG8_LAS const unsigned* hl = (PG8_LAS const unsigned*)lds;
                unsigned A[16], B[16];
#pragma unroll
                for (int i = 0; i < 16; ++i) { A[i] = hl[i * 256 + c * 128 + row]; B[i] = hl[(16 + i) * 256 + c * 128 + row]; }
                merge16_desc(A, B);
#pragma unroll
                for (int i = 0; i < 16; ++i) l1[i * 256 + c * 128 + row] = A[i];
            }
            __syncthreads();
            if (tid < 256) {
                const int row = tid & 127, hw = tid >> 7;
                float fa[16], fb[16];
#pragma unroll
                for (int i = 0; i < 16; ++i) { fa[i] = key2f(l1[i * 256 + row] & ~127u); fb[i] = key2f(l1[i * 256 + 128 + row] & ~127u); }
                unsigned T[16], G[16];
                if (hw == 0) { T[0] = (f2key(fa[0] + fb[0]) & ~255u) | 0u; T[1] = (f2key(fa[0] + fb[1]) & ~255u) | 1u; T[2] = (f2key(fa[0] + fb[2]) & ~255u) | 2u; T[3] = (f2key(fa[0] + fb[3]) & ~255u) | 3u; T[4] = (f2key(fa[0] + fb[4]) & ~255u) | 4u; T[5] = (f2key(fa[0] + fb[5]) & ~255u) | 5u; T[6] = (f2key(fa[0] + fb[6]) & ~255u) | 6u; T[7] = (f2key(fa[0] + fb[7]) & ~255u) | 7u; T[8] = (f2key(fa[0] + fb[8]) & ~255u) | 8u; T[9] = (f2key(fa[0] + fb[9]) & ~255u) | 9u; T[10] = (f2key(fa[0] + fb[10]) & ~255u) | 10u; T[11] = (f2key(fa[0] + fb[11]) & ~255u) | 11u; T[12] = (f2key(fa[0] + fb[12]) & ~255u) | 12u; T[13] = (f2key(fa[0] + fb[13]) & ~255u) | 13u; T[14] = (f2key(fa[0] + fb[14]) & ~255u) | 14u; T[15] = (f2key(fa[0] + fb[15]) & ~255u) | 15u; G[0] = (f2key(fa[4] + fb[0]) & ~255u) | 64u; G[1] = (f2key(fa[4] + fb[1]) & ~255u) | 65u; G[2] = (f2key(fa[4] + fb[2]) & ~255u) | 66u; G[3] = (f2key(fa[5] + fb[0]) & ~255u) | 80u; G[4] = (f2key(fa[5] + fb[1]) & ~255u) | 81u; G[5] = (f2key(fa[6] + fb[0]) & ~255u) | 96u; G[6] = (f2key(fa[6] + fb[1]) & ~255u) | 97u; G[7] = (f2key(fa[7] + fb[0]) & ~255u) | 112u; G[8] = (f2key(fa[7] + fb[1]) & ~255u) | 113u; G[9] = 0u; G[10] = 0u; G[11] = 0u; G[12] = 0u; G[13] = 0u; G[14] = 0u; G[15] = 0u; }
                else { T[0] = (f2key(fa[1] + fb[0]) & ~255u) | 16u; T[1] = (f2key(fa[1] + fb[1]) & ~255u) | 17u; T[2] = (f2key(fa[1] + fb[2]) & ~255u) | 18u; T[3] = (f2key(fa[1] + fb[3]) & ~255u) | 19u; T[4] = (f2key(fa[1] + fb[4]) & ~255u) | 20u; T[5] = (f2key(fa[1] + fb[5]) & ~255u) | 21u; T[6] = (f2key(fa[1] + fb[6]) & ~255u) | 22u; T[7] = (f2key(fa[1] + fb[7]) & ~255u) | 23u; T[8] = (f2key(fa[2] + fb[0]) & ~255u) | 32u; T[9] = (f2key(fa[2] + fb[1]) & ~255u) | 33u; T[10] = (f2key(fa[2] + fb[2]) & ~255u) | 34u; T[11] = (f2key(fa[2] + fb[3]) & ~255u) | 35u; T[12] = (f2key(fa[2] + fb[4]) & ~255u) | 36u; T[13] = (f2key(fa[3] + fb[0]) & ~255u) | 48u; T[14] = (f2key(fa[3] + fb[1]) & ~255u) | 49u; T[15] = (f2key(fa[3] + fb[2]) & ~255u) | 50u; G[0] = (f2key(fa[3] + fb[3]) & ~255u) | 51u; G[1] = (f2key(fa[8] + fb[0]) & ~255u) | 128u; G[2] = (f2key(fa[9] + fb[0]) & ~255u) | 144u; G[3] = (f2key(fa[10] + fb[0]) & ~255u) | 160u; G[4] = (f2key(fa[11] + fb[0]) & ~255u) | 176u; G[5] = (f2key(fa[12] + fb[0]) & ~255u) | 192u; G[6] = (f2key(fa[13] + fb[0]) & ~255u) | 208u; G[7] = (f2key(fa[14] + fb[0]) & ~255u) | 224u; G[8] = (f2key(fa[15] + fb[0]) & ~255u) | 240u; G[9] = 0u; G[10] = 0u; G[11] = 0u; G[12] = 0u; G[13] = 0u; G[14] = 0u; G[15] = 0u; }
                sort16_desc(T); sort16_desc(G); merge16_desc(T, G);
                PG8_LAS unsigned* l2 = (PG8_LAS unsigned*)lds;
#pragma unroll
                for (int i = 0; i < 16; ++i) l2[(hw * 16 + i) * 128 + row] = T[i];
            }
            __syncthreads();
            if (tid < 256) {
                const int row = tid & 127, hw = tid >> 7;
                PG8_LAS const unsigned* l2 = (PG8_LAS const unsigned*)lds;
                unsigned T[16], G[16];
#pragma unroll
                for (int i = 0; i < 16; ++i) { T[i] = l2[i * 128 + row]; G[i] = l2[(16 + i) * 128 + row]; }
                merge16_desc(T, G);
                const size_t o = ((size_t)(u.pm * BM + ai * HALF + row) * 8 + h) * 16;
#pragma unroll
                for (int k = 0; k < 16; ++k) if ((k >> 3) == hw) {
                    const unsigned code = T[k] & 255u; const int i = code >> 4, j = code & 15;
                    const int i1 = 127 - (int)(l1[i * 256 + row] & 127u), i2 = 127 - (int)(l1[j * 256 + 128 + row] & 127u);
                    tki[o + k] = i1 * 128 + i2; tks[o + k] = key2f(T[k] & ~255u);
                }
            }
            __syncthreads();
        }
    }
};
template <class Epi, class Sched, bool ALIGN_EPI = false, bool SP2 = false>
__device__ __forceinline__ void gemm_phase(PG8_LAS unsigned char* lds, const Gemm g, const Sched& S, const Epi& E) {
    const int tid = threadIdx.x, wid = __builtin_amdgcn_readfirstlane(tid >> 6), lane = tid & 63, wr = wid >> 2, wc = wid & 3, fr = lane & 15, fq = lane >> 4;
    const int K = g.K, nt = K / BK;
    unsigned voffA[2], voffB[2];
#pragma unroll
    for (int i = 0; i < 2; ++i) { int R, C; stage_rc(tid * 16 + i * 8192, R, C); const int Rb = Epi::PERM ? ((R & ~31) + perm32(R & 31)) : R;
        voffA[i] = (unsigned)(R * K + C) * 2u; voffB[i] = (unsigned)(Rb * K + C) * 2u; }
    const size_t kstep = (size_t)(BK * 2);
    const size_t hstep = (size_t)HALF * K * 2;
    const size_t tstep = 2 * hstep;
    const unsigned ldsw = (unsigned)wid * 1024u;
    const int aoff = lds_byte(wr * 64 + fr, fq * 8), boff = lds_byte(wc * 32 + fr, fq * 8);
#define PG8_SA(b, h) (((b) * 2 + (h)) * HTB)
#define PG8_SB(b, h) ((4 + (b) * 2 + (h)) * HTB)
#define PG8_STAGE(bufoff, gbase, voff) do { _Pragma("unroll") for (int _i = 0; _i < 2; ++_i) \
        __builtin_amdgcn_global_load_lds((const unsigned*)((const char*)(gbase) + (voff)[_i]), (PG8_LAS unsigned*)(lds + (bufoff) + ldsw + _i * 8192), 16, 0, 0); } while (0)
#define PG8_LDA(dst, b, h) do { _Pragma("unroll") for (int m = 0; m < 4; ++m) _Pragma("unroll") for (int k = 0; k < 2; ++k) dst[m][k] = *(const PG8_LAS bf16x8*)(lds + PG8_SA(b, h) + aoff + m * 2048 + k * 1024); } while (0)
#define PG8_LDB(dst, b, h) do { _Pragma("unroll") for (int n = 0; n < 2; ++n) _Pragma("unroll") for (int k = 0; k < 2; ++k) dst[n][k] = *(const PG8_LAS bf16x8*)(lds + PG8_SB(b, h) + boff + n * 2048 + k * 1024); } while (0)
#define PG8_MMA(ai, bj, At, Bt) do { __builtin_amdgcn_s_setprio(1); _Pragma("unroll") for (int m = 0; m < 4; ++m) _Pragma("unroll") for (int n = 0; n < 2; ++n) _Pragma("unroll") for (int k = 0; k < 2; ++k) \
        acc[ai][bj][m][n] = __builtin_amdgcn_mfma_f32_16x16x32_bf16(Bt[n][k], At[m][k], acc[ai][bj][m][n], 0, 0, 0); __builtin_amdgcn_s_setprio(0); } while (0)
#define PG8_WAIT_V(n) asm volatile("s_waitcnt vmcnt(" #n ")" ::: "memory")
#define PG8_WAIT_L(n) asm volatile("s_waitcnt lgkmcnt(" #n ")" ::: "memory")
#define PG8_BAR __builtin_amdgcn_s_barrier()
#define PG8_SCHED __builtin_amdgcn_sched_barrier(0)
    Unit cur, nxt; int ui = 0;
    if (!S.next(0, cur)) return;
    f32x4 acc[2][2][4][2];
#pragma unroll
    for (int a = 0; a < 2; ++a)
#pragma unroll
        for (int b = 0; b < 2; ++b)
#pragma unroll
            for (int m = 0; m < 4; ++m)
#pragma unroll
                for (int n = 0; n < 2; ++n) acc[a][b][m][n] = (f32x4){0.f, 0.f, 0.f, 0.f};
    bf16x8 At[4][2], B0[2][2], B1[2][2];
    const char* cA = (const char*)g.A + (size_t)cur.pm * tstep; const char* cB = (const char*)g.Bt + (size_t)cur.pn * tstep;
    S.a_ready(cur);
    if constexpr (SP2) {
        PG8_STAGE(PG8_SB(0, 0), cB, voffB); PG8_STAGE(PG8_SB(0, 1), cB + hstep, voffB); PG8_STAGE(PG8_SA(0, 0), cA, voffA); PG8_STAGE(PG8_SA(0, 1), cA + hstep, voffA);
        if (wr == 1) PG8_BAR;
        PG8_WAIT_V(2); PG8_BAR;
        PG8_STAGE(PG8_SB(1, 0), cB + kstep, voffB); PG8_STAGE(PG8_SA(1, 0), cA + kstep, voffA); PG8_STAGE(PG8_SB(1, 1), cB + hstep + kstep, voffB);
        PG8_WAIT_V(6); PG8_BAR;
    } else {
        PG8_STAGE(PG8_SB(0, 0), cB, voffB); PG8_STAGE(PG8_SA(0, 0), cA, voffA); PG8_STAGE(PG8_SB(0, 1), cB + hstep, voffB); PG8_STAGE(PG8_SA(0, 1), cA + hstep, voffA);
        if (wr == 1) PG8_BAR;
        PG8_WAIT_V(4); PG8_BAR;
        PG8_STAGE(PG8_SB(1, 0), cB + kstep, voffB); PG8_STAGE(PG8_SA(1, 0), cA + kstep, voffA); PG8_STAGE(PG8_SB(1, 1), cB + hstep + kstep, voffB);
        PG8_WAIT_V(6); PG8_BAR;
    }
    for (;;) {
        const bool has_next = S.next(ui + 1, nxt);
        const char* nA = has_next ? (const char*)g.A + (size_t)nxt.pm * tstep : cA; const char* nB = has_next ? (const char*)g.Bt + (size_t)nxt.pn * tstep : cB;
        for (int t = 0; t < nt; t += 2) {
            const bool last = (t == nt - 2);
            const char* a1 = cA + (size_t)(t + 1) * kstep;
            const char* a2 = last ? nA : cA + (size_t)(t + 2) * kstep; const char* b2 = last ? nB : cB + (size_t)(t + 2) * kstep;
            const char* a3 = a2 + kstep; const char* b3 = b2 + kstep;
            if (last && has_next) S.a_ready(nxt);
            if constexpr (SP2) {
            PG8_LDB(B0, 0, 0); PG8_LDB(B1, 0, 1); PG8_SCHED; PG8_LDA(At, 0, 0); PG8_STAGE(PG8_SA(1, 1), a1 + hstep, voffA);
            PG8_WAIT_V(8); PG8_WAIT_L(0); PG8_BAR; PG8_MMA(0, 0, At, B0); PG8_MMA(0, 1, At, B1); PG8_BAR; PG8_SCHED;
            PG8_LDA(At, 0, 1); PG8_STAGE(PG8_SB(0, 0), b2, voffB); PG8_STAGE(PG8_SB(0, 1), b2 + hstep, voffB); PG8_STAGE(PG8_SA(0, 0), a2, voffA);
            PG8_WAIT_V(8); PG8_WAIT_L(0); PG8_BAR; PG8_MMA(1, 0, At, B0); PG8_MMA(1, 1, At, B1); PG8_BAR; PG8_SCHED;
            PG8_LDB(B0, 1, 0); PG8_LDB(B1, 1, 1); PG8_SCHED; PG8_LDA(At, 1, 0); PG8_STAGE(PG8_SA(0, 1), a2 + hstep, voffA);
            PG8_WAIT_V(8); PG8_WAIT_L(0); PG8_BAR; PG8_MMA(0, 0, At, B0); PG8_MMA(0, 1, At, B1); PG8_BAR; PG8_SCHED;
            PG8_LDA(At, 1, 1); PG8_STAGE(PG8_SB(1, 0), b3, voffB); PG8_STAGE(PG8_SB(1, 1), b3 + hstep, voffB); PG8_STAGE(PG8_SA(1, 0), a3, voffA);
            PG8_WAIT_V(8); PG8_WAIT_L(0); PG8_BAR; PG8_MMA(1, 0, At, B0); PG8_MMA(1, 1, At, B1); PG8_BAR; PG8_SCHED;
            } else {
            PG8_LDB(B0, 0, 0); PG8_SCHED; PG8_LDA(At, 0, 0); PG8_STAGE(PG8_SA(1, 1), a1 + hstep, voffA);
            PG8_WAIT_L(8); PG8_BAR; PG8_WAIT_L(0); PG8_MMA(0, 0, At, B0); PG8_BAR; PG8_SCHED;
            PG8_LDB(B1, 0, 1); PG8_STAGE(PG8_SB(0, 0), b2, voffB);
            PG8_BAR; PG8_WAIT_L(0); PG8_MMA(0, 1, At, B1); PG8_BAR;
            PG8_LDA(At, 0, 1); PG8_STAGE(PG8_SA(0, 0), a2, voffA);
            PG8_BAR; PG8_WAIT_L(0); PG8_MMA(1, 0, At, B0); PG8_BAR; PG8_SCHED;
            PG8_STAGE(PG8_SB(0, 1), b2 + hstep, voffB);
            PG8_WAIT_V(6); PG8_BAR; PG8_MMA(1, 1, At, B1); PG8_BAR;
            PG8_LDB(B0, 1, 0); PG8_SCHED; PG8_LDA(At, 1, 0); PG8_STAGE(PG8_SA(0, 1), a2 + hstep, voffA);
            PG8_WAIT_L(8); PG8_BAR; PG8_WAIT_L(0); PG8_MMA(0, 0, At, B0); PG8_BAR; PG8_SCHED;
            PG8_LDB(B1, 1, 1); PG8_STAGE(PG8_SB(1, 0), b3, voffB);
            PG8_BAR; PG8_WAIT_L(0); PG8_MMA(0, 1, At, B1); PG8_BAR;
            PG8_LDA(At, 1, 1); PG8_STAGE(PG8_SA(1, 0), a3, voffA);
            PG8_BAR; PG8_WAIT_L(0); PG8_MMA(1, 0, At, B0); PG8_BAR; PG8_SCHED;
            PG8_STAGE(PG8_SB(1, 1), b3 + hstep, voffB);
            PG8_WAIT_V(6); PG8_BAR; PG8_MMA(1, 1, At, B1); PG8_BAR;
            }
        }
        if constexpr (ALIGN_EPI) { if (wr == 0) PG8_BAR; }
        if constexpr (!Epi::AFTER_DRAIN) { E(acc, cur, wr, wc, fr, fq); S.done(cur); }
        if (!has_next) break;
#pragma unroll
        for (int a = 0; a < 2; ++a)
#pragma unroll
            for (int b = 0; b < 2; ++b)
#pragma unroll
                for (int m = 0; m < 4; ++m)
#pragma unroll
                    for (int n = 0; n < 2; ++n) acc[a][b][m][n] = (f32x4){0.f, 0.f, 0.f, 0.f};
        cur = nxt; cA = nA; cB = nB; ++ui;
        if constexpr (ALIGN_EPI) { if (wr == 1) PG8_BAR; }
    }
    PG8_WAIT_V(0);
    if constexpr (!ALIGN_EPI) { if (wr == 0) PG8_BAR; }
    PG8_BAR;
    if constexpr (Epi::AFTER_DRAIN) { E.fused(acc, cur, wr, wc, fr, fq, lds, wid, lane); S.done(cur); }
#undef PG8_SA
#undef PG8_SB
#undef PG8_STAGE
#undef PG8_LDA
#undef PG8_LDB
#undef PG8_MMA
#undef PG8_WAIT_V
#undef PG8_WAIT_L
#undef PG8_BAR
#undef PG8_SCHED
}
}
namespace attn {
typedef unsigned short bf16_t;
using bf16x8 = __attribute__((ext_vector_type(8))) short;
using s16x4 = __attribute__((ext_vector_type(4))) short;
using f32x16 = __attribute__((ext_vector_type(16))) float;
using f32x4 = __attribute__((ext_vector_type(4))) float;
using u32x4 = __attribute__((ext_vector_type(4))) unsigned;
typedef __attribute__((address_space(3))) const char* lds_cptr;
typedef __attribute__((address_space(3))) char* lds_ptr;
typedef short v4i16_t __attribute__((ext_vector_type(4)));
typedef float f32x2_t __attribute__((ext_vector_type(2))); typedef __bf16 bf16x2_t __attribute__((ext_vector_type(2)));
constexpr int NT = SEQ / 64;
constexpr int LDS_WSF = 9 * 16384;
constexpr int ATTN_LDS_BYTES = LDS_WSF + 8 * 256;
__device__ __forceinline__ int crow(int r, int hi) { return (r & 3) + 8 * (r >> 2) + 4 * hi; }
__device__ __forceinline__ unsigned cvtpk_s(float lo, float hi) { f32x2_t v = {lo, hi}; bf16x2_t b = __builtin_convertvector(v, bf16x2_t); return __builtin_bit_cast(unsigned, b); }
__device__ __forceinline__ void glds16(const void* gsrc, unsigned lds_dst) { unsigned keep;
    asm volatile("s_mov_b32 %0, m0\n\ts_mov_b32 m0, %2\n\ts_nop 0\n\tglobal_load_lds_dwordx4 %1, off\n\ts_mov_b32 m0, %0" : "=&s"(keep) : "v"(gsrc), "s"(lds_dst) : "memory"); }
__device__ __forceinline__ void glds16s(const void* sbase, unsigned voff, unsigned lds_dst) { unsigned keep;
    asm volatile("s_mov_b32 %0, m0\n\ts_mov_b32 m0, %3\n\ts_nop 0\n\tglobal_load_lds_dwordx4 %1, %2\n\ts_mov_b32 m0, %0" : "=&s"(keep) : "v"(voff), "s"(sbase), "s"(lds_dst) : "memory"); }
__device__ __forceinline__ s16x4 vtr(lds_cptr p) { return __builtin_bit_cast(s16x4, __builtin_amdgcn_ds_read_tr16_b64_v4i16((__attribute__((address_space(3))) v4i16_t*)p)); }
__device__ __forceinline__ float fadd_s(float a, float b) { float r; asm("v_add_f32_e32 %0, %1, %2" : "=v"(r) : "v"(a), "v"(b)); return r; }
__device__ __forceinline__ float bf2f(short s) { return __uint_as_float(((unsigned)(unsigned short)s) << 16); }
#define ATT_WAIT_BAR(N) asm volatile("s_waitcnt vmcnt(" #N ") lgkmcnt(0)\n\ts_barrier" ::: "memory")

struct UnitDesc {
    const bf16_t* Qw;
    const bf16_t* Kt; int KP;
    const bf16_t* Vt; int VP;
    bf16_t* Ow;
};

template <int DV>
__device__ __forceinline__ void attn_unit(const UnitDesc& U, char* shm, float lam, const float* subw) {
    constexpr int KCH = (DV == 64) ? 8 : 16, KS = KCH * 1024, ND = DV / 32, VS = ND * 4096, NPK = KCH / 8, NPV = ND / 2;
    constexpr int NKS = 4, VAH = 2, NVS = 4; constexpr int LDS_K = 0, LDS_V = NKS * KS;
    const int tid = threadIdx.x, lane = tid & 63, r32 = lane & 31, hi = lane >> 5; const int wid = __builtin_amdgcn_readfirstlane(tid >> 6);
    const unsigned lds0 = (unsigned)(uintptr_t)shm;
    const int map = (DV == 128) ? (wid >> 2) : 0;
    unsigned koff, voff; unsigned kdst[NPK], vdst[NPV];
    { const int key = 8 * wid + (lane >> 3), pp = lane & 7;
      koff = (unsigned)(key * U.KP + (pp ^ ((key >> 1) & 7)) * 8) * 2u; voff = (unsigned)(key * U.VP + ((((pp >> 2) ^ ((key >> 1) & 1)) << 2) + (pp & 3)) * 8) * 2u;
#pragma unroll
      for (int pc = 0; pc < NPK; ++pc) kdst[pc] = lds0 + LDS_K + pc * 8192 + wid * 1024;
#pragma unroll
      for (int pc = 0; pc < NPV; ++pc) vdst[pc] = lds0 + LDS_V + pc * 8192 + wid * 1024; }
#define DMA_K(t, slot) do { _Pragma("unroll") for (int pc_ = 0; pc_ < NPK; ++pc_) glds16s(U.Kt + (size_t)(t) * 64 * U.KP + pc_ * 64, koff, (unsigned)__builtin_amdgcn_readfirstlane(kdst[pc_] + (slot) * KS)); } while (0)
#define DMA_V(t, slot) do { _Pragma("unroll") for (int pc_ = 0; pc_ < NPV; ++pc_) glds16s(U.Vt + (size_t)(t) * 64 * U.VP + pc_ * 64, voff, (unsigned)__builtin_amdgcn_readfirstlane(vdst[pc_] + (slot) * VS)); } while (0)
    const lds_cptr shm3 = (lds_cptr)shm;
    lds_cptr kpb[4];
#pragma unroll
    for (int d0 = 0; d0 < 4; ++d0) kpb[d0] = shm3 + LDS_K + map * 8192 + r32 * 128 + (((2 * d0 + hi) ^ ((r32 >> 1) & 7)) << 4);
    lds_cptr vpb[2];
    { const int q4 = (lane & 15) >> 2, swz = (q4 >> 1) & 1;
#pragma unroll
      for (int h = 0; h < 2; ++h) vpb[h] = shm3 + LDS_V + (4 * hi + q4) * 128 + ((h ^ swz) << 6) + ((lane >> 4) & 1) * 32 + (lane & 3) * 8; }
    bf16x8 qr[4];
#pragma unroll
    for (int d0 = 0; d0 < 4; ++d0) qr[d0] = *reinterpret_cast<const bf16x8*>(U.Qw + (size_t)r32 * 512 + d0 * 16 + hi * 8);
    const f32x16 negm = f32x16{};
    f32x16 o[ND];
#pragma unroll
    for (int d = 0; d < ND; ++d) o[d] = f32x16{};
    f32x4 ls = {0.f, 0.f, 0.f, 0.f};
    const short one_ = (((lane >> 4) & 1) == ((lane & 15) >> 3)) ? (short)0x3F80 : (short)0;
    const bf16x8 onesb = {one_, one_, one_, one_, one_, one_, one_, one_};
    f32x16 p0, p1; u32x4 pw[4]; bf16x8 kf[8]; s16x4 vlo[4 * ND], vhi[4 * ND];
#define SBAR() __builtin_amdgcn_sched_barrier(0)
#define PIN(x) asm volatile("" : "+v"(x))
#define MF(a, b, c) __builtin_amdgcn_mfma_f32_32x32x16_bf16(a, b, c, 0, 0, 0)
#define EX(v) __builtin_amdgcn_exp2f(v)
#define MF16(a, b, c) __builtin_amdgcn_mfma_f32_16x16x32_bf16(a, b, c, 0, 0, 0)
#define VRD(i) do { vlo[i] = vtr(vpb[((i) % ND) & 1] + vo_ + (((i) % ND) >> 1) * 8192 + ((i) / ND) * 2048); vhi[i] = vtr(vpb[((i) % ND) & 1] + vo_ + (((i) % ND) >> 1) * 8192 + ((i) / ND) * 2048 + 1024); } while (0)
#define VFR(i) (bf16x8){vlo[i][0], vlo[i][1], vlo[i][2], vlo[i][3], vhi[i][0], vhi[i][1], vhi[i][2], vhi[i][3]}
#define KRD(j) do { kf[j] = *(const __attribute__((address_space(3))) bf16x8*)(kpb[(j) >> 1] + kn_ + ((j) & 1) * 4096); } while (0)
#define KRDC(j) do { kf[j] = *(const __attribute__((address_space(3))) bf16x8*)(kpb[(j) >> 1] + kc_ + ((j) & 1) * 4096); } while (0)
#define WB(n) do { if ((n) == 0) ATT_WAIT_BAR(0); else if ((n) == 1) ATT_WAIT_BAR(1); else if ((n) == 2) ATT_WAIT_BAR(2); else if ((n) == 3) ATT_WAIT_BAR(3); else if ((n) == 4) ATT_WAIT_BAR(4); else if ((n) == 5) ATT_WAIT_BAR(5); else ATT_WAIT_BAR(10); } while (0)
#define STEP64(t, GK, GV, GL, kq, k1, k3, vq, v3) do { SBAR(); \
    constexpr int vo_ = (vq) * VS, kc_ = (kq) * KS, kn_ = (k1) * KS; (void)kc_; (void)kn_; \
    VRD(0); SBAR(); p0 = MF(kf[0], qr[0], negm); SBAR(); \
    VRD(1); SBAR(); p1 = MF(kf[1], qr[0], negm); SBAR(); \
    VRD(2); SBAR(); p0 = MF(kf[2], qr[1], p0); SBAR(); \
    VRD(3); SBAR(); p1 = MF(kf[3], qr[1], p1); SBAR(); \
    VRD(4); SBAR(); p0 = MF(kf[4], qr[2], p0); SBAR(); \
    VRD(5); SBAR(); p1 = MF(kf[5], qr[2], p1); SBAR(); \
    VRD(6); SBAR(); p0 = MF(kf[6], qr[3], p0); SBAR(); \
    VRD(7); SBAR(); p1 = MF(kf[7], qr[3], p1); SBAR(); \
    if (GK) { DMA_K((t) + 3, k3); } if (GV) { DMA_V((t) + VAH, v3); } \
    if (GL) { KRD(0); } SBAR(); ls = MF16(__builtin_bit_cast(bf16x8, pw[0]), onesb, ls); o[0] = MF(__builtin_bit_cast(bf16x8, pw[0]), VFR(0), o[0]); p0[0] = EX(p0[0]); p0[1] = EX(p0[1]); p0[2] = EX(p0[2]); p0[3] = EX(p0[3]); PIN(p0); SBAR(); \
    if (GL) { KRD(1); } SBAR(); o[1] = MF(__builtin_bit_cast(bf16x8, pw[0]), VFR(1), o[1]); p0[4] = EX(p0[4]); p0[5] = EX(p0[5]); p0[6] = EX(p0[6]); p0[7] = EX(p0[7]); PIN(p0); SBAR(); \
    if (GL) { KRD(2); } SBAR(); ls = MF16(__builtin_bit_cast(bf16x8, pw[1]), onesb, ls); o[0] = MF(__builtin_bit_cast(bf16x8, pw[1]), VFR(2), o[0]); p0[8] = EX(p0[8]); p0[9] = EX(p0[9]); p0[10] = EX(p0[10]); p0[11] = EX(p0[11]); pw[0][0] = cvtpk_s(p0[0], p0[1]); pw[0][1] = cvtpk_s(p0[2], p0[3]); PIN(p0); PIN(pw[0]); SBAR(); \
    if (GL) { KRD(3); } SBAR(); o[1] = MF(__builtin_bit_cast(bf16x8, pw[1]), VFR(3), o[1]); p0[12] = EX(p0[12]); p0[13] = EX(p0[13]); p0[14] = EX(p0[14]); p0[15] = EX(p0[15]); pw[0][2] = cvtpk_s(p0[4], p0[5]); pw[0][3] = cvtpk_s(p0[6], p0[7]); PIN(p0); PIN(pw[0]); SBAR(); \
    if (GL) { KRD(4); } SBAR(); ls = MF16(__builtin_bit_cast(bf16x8, pw[2]), onesb, ls); o[0] = MF(__builtin_bit_cast(bf16x8, pw[2]), VFR(4), o[0]); p1[0] = EX(p1[0]); p1[1] = EX(p1[1]); p1[2] = EX(p1[2]); p1[3] = EX(p1[3]); pw[1][0] = cvtpk_s(p0[8], p0[9]); pw[1][1] = cvtpk_s(p0[10], p0[11]); PIN(p1); PIN(pw[1]); SBAR(); \
    if (GL) { KRD(5); } SBAR(); o[1] = MF(__builtin_bit_cast(bf16x8, pw[2]), VFR(5), o[1]); p1[4] = EX(p1[4]); p1[5] = EX(p1[5]); p1[6] = EX(p1[6]); p1[7] = EX(p1[7]); pw[1][2] = cvtpk_s(p0[12], p0[13]); pw[1][3] = cvtpk_s(p0[14], p0[15]); PIN(p1); PIN(pw[1]); SBAR(); \
    if (GL) { KRD(6); } SBAR(); ls = MF16(__builtin_bit_cast(bf16x8, pw[3]), onesb, ls); o[0] = MF(__builtin_bit_cast(bf16x8, pw[3]), VFR(6), o[0]); p1[8] = EX(p1[8]); p1[9] = EX(p1[9]); p1[10] = EX(p1[10]); p1[11] = EX(p1[11]); pw[2][0] = cvtpk_s(p1[0], p1[1]); pw[2][1] = cvtpk_s(p1[2], p1[3]); PIN(p1); PIN(pw[2]); SBAR(); \
    if (GL) { KRD(7); } SBAR(); o[1] = MF(__builtin_bit_cast(bf16x8, pw[3]), VFR(7), o[1]); p1[12] = EX(p1[12]); p1[13] = EX(p1[13]); p1[14] = EX(p1[14]); p1[15] = EX(p1[15]); pw[2][2] = cvtpk_s(p1[4], p1[5]); pw[2][3] = cvtpk_s(p1[6], p1[7]); PIN(p1); PIN(pw[2]); SBAR(); \
    pw[3][0] = cvtpk_s(p1[8], p1[9]); pw[3][1] = cvtpk_s(p1[10], p1[11]); pw[3][2] = cvtpk_s(p1[12], p1[13]); pw[3][3] = cvtpk_s(p1[14], p1[15]); SBAR(); \
  } while (0)
#define STEP128(t, GK, GV, GL, kq, k1, k3, vq, v3) do { SBAR(); \
    constexpr int vo_ = (vq) * VS, kc_ = (kq) * KS, kn_ = (k1) * KS; (void)kc_; (void)kn_; \
    SBAR(); p0 = MF(kf[0], qr[0], negm); SBAR(); \
    SBAR(); p1 = MF(kf[1], qr[0], negm); SBAR(); \
    SBAR(); p0 = MF(kf[2], qr[1], p0); SBAR(); \
    SBAR(); p1 = MF(kf[3], qr[1], p1); SBAR(); \
    VRD(0); SBAR(); p0 = MF(kf[4], qr[2], p0); SBAR(); \
    VRD(1); SBAR(); p1 = MF(kf[5], qr[2], p1); SBAR(); \
    VRD(2); SBAR(); p0 = MF(kf[6], qr[3], p0); SBAR(); \
    VRD(3); SBAR(); p1 = MF(kf[7], qr[3], p1); SBAR(); \
    if (GK) { DMA_K((t) + 3, k3); } if (GV) { DMA_V((t) + VAH, v3); } \
    VRD(4); SBAR(); ls = MF16(__builtin_bit_cast(bf16x8, pw[0]), onesb, ls); o[0] = MF(__builtin_bit_cast(bf16x8, pw[0]), VFR(0), o[0]); p0[0] = EX(p0[0]); p0[1] = EX(p0[1]); PIN(p0); SBAR(); \
    VRD(5); SBAR(); o[1] = MF(__builtin_bit_cast(bf16x8, pw[0]), VFR(1), o[1]); p0[2] = EX(p0[2]); p0[3] = EX(p0[3]); PIN(p0); SBAR(); \
    VRD(6); SBAR(); o[2] = MF(__builtin_bit_cast(bf16x8, pw[0]), VFR(2), o[2]); p0[4] = EX(p0[4]); p0[5] = EX(p0[5]); PIN(p0); SBAR(); \
    VRD(7); SBAR(); o[3] = MF(__builtin_bit_cast(bf16x8, pw[0]), VFR(3), o[3]); p0[6] = EX(p0[6]); p0[7] = EX(p0[7]); PIN(p0); SBAR(); \
    VRD(8); SBAR(); ls = MF16(__builtin_bit_cast(bf16x8, pw[1]), onesb, ls); o[0] = MF(__builtin_bit_cast(bf16x8, pw[1]), VFR(4), o[0]); p0[8] = EX(p0[8]); p0[9] = EX(p0[9]); pw[0][0] = cvtpk_s(p0[0], p0[1]); PIN(p0); PIN(pw[0]); SBAR(); \
    VRD(9); SBAR(); o[1] = MF(__builtin_bit_cast(bf16x8, pw[1]), VFR(5), o[1]); p0[10] = EX(p0[10]); p0[11] = EX(p0[11]); pw[0][1] = cvtpk_s(p0[2], p0[3]); PIN(p0); PIN(pw[0]); SBAR(); \
    VRD(10); SBAR(); o[2] = MF(__builtin_bit_cast(bf16x8, pw[1]), VFR(6), o[2]); p0[12] = EX(p0[12]); p0[13] = EX(p0[13]); pw[0][2] = cvtpk_s(p0[4], p0[5]); PIN(p0); PIN(pw[0]); SBAR(); \
    VRD(11); SBAR(); o[3] = MF(__builtin_bit_cast(bf16x8, pw[1]), VFR(7), o[3]); p0[14] = EX(p0[14]); p0[15] = EX(p0[15]); pw[0][3] = cvtpk_s(p0[6], p0[7]); PIN(p0); PIN(pw[0]); SBAR(); \
    VRD(12); if (GL) { KRD(0); } SBAR(); ls = MF16(__builtin_bit_cast(bf16x8, pw[2]), onesb, ls); o[0] = MF(__builtin_bit_cast(bf16x8, pw[2]), VFR(8), o[0]); p1[0] = EX(p1[0]); p1[1] = EX(p1[1]); pw[1][0] = cvtpk_s(p0[8], p0[9]); PIN(p1); PIN(pw[1]); SBAR(); \
    VRD(13); if (GL) { KRD(1); } SBAR(); o[1] = MF(__builtin_bit_cast(bf16x8, pw[2]), VFR(9), o[1]); p1[2] = EX(p1[2]); p1[3] = EX(p1[3]); pw[1][1] = cvtpk_s(p0[10], p0[11]); PIN(p1); PIN(pw[1]); SBAR(); \
    VRD(14); if (GL) { KRD(2); } SBAR(); o[2] = MF(__builtin_bit_cast(bf16x8, pw[2]), VFR(10), o[2]); p1[4] = EX(p1[4]); p1[5] = EX(p1[5]); pw[1][2] = cvtpk_s(p0[12], p0[13]); PIN(p1); PIN(pw[1]); SBAR(); \
    VRD(15); if (GL) { KRD(3); } SBAR(); o[3] = MF(__builtin_bit_cast(bf16x8, pw[2]), VFR(11), o[3]); p1[6] = EX(p1[6]); p1[7] = EX(p1[7]); pw[1][3] = cvtpk_s(p0[14], p0[15]); PIN(p1); PIN(pw[1]); SBAR(); \
    if (GL) { KRD(4); } SBAR(); ls = MF16(__builtin_bit_cast(bf16x8, pw[3]), onesb, ls); o[0] = MF(__builtin_bit_cast(bf16x8, pw[3]), VFR(12), o[0]); p1[8] = EX(p1[8]); p1[9] = EX(p1[9]); pw[2][0] = cvtpk_s(p1[0], p1[1]); PIN(p1); PIN(pw[2]); SBAR(); \
    if (GL) { KRD(5); } SBAR(); o[1] = MF(__builtin_bit_cast(bf16x8, pw[3]), VFR(13), o[1]); p1[10] = EX(p1[10]); p1[11] = EX(p1[11]); pw[2][1] = cvtpk_s(p1[2], p1[3]); PIN(p1); PIN(pw[2]); SBAR(); \
    if (GL) { KRD(6); } SBAR(); o[2] = MF(__builtin_bit_cast(bf16x8, pw[3]), VFR(14), o[2]); p1[12] = EX(p1[12]); p1[13] = EX(p1[13]); pw[2][2] = cvtpk_s(p1[4], p1[5]); PIN(p1); PIN(pw[2]); SBAR(); \
    if (GL) { KRD(7); } SBAR(); o[3] = MF(__builtin_bit_cast(bf16x8, pw[3]), VFR(15), o[3]); p1[14] = EX(p1[14]); p1[15] = EX(p1[15]); pw[2][3] = cvtpk_s(p1[6], p1[7]); PIN(p1); PIN(pw[2]); SBAR(); \
    pw[3][0] = cvtpk_s(p1[8], p1[9]); pw[3][1] = cvtpk_s(p1[10], p1[11]); pw[3][2] = cvtpk_s(p1[12], p1[13]); pw[3][3] = cvtpk_s(p1[14], p1[15]); SBAR(); \
  } while (0)
#define STEP64D(N0, N1, O0, O1, t, GK, GV, GL, kq, k1, k3, vq, v3) do { SBAR(); \
    constexpr int vo_ = (vq) * VS, kn_ = (k1) * KS; (void)kn_; \
    VRD(0); SBAR(); N0 = MF(kf[0], qr[0], negm); O1[0] = EX(O1[0]); O1[1] = EX(O1[1]); pw[1][2] = cvtpk_s(O0[12], O0[13]); PIN(pw[1]); PIN(O1); SBAR(); \
    VRD(1); SBAR(); N1 = MF(kf[1], qr[0], negm); O1[2] = EX(O1[2]); O1[3] = EX(O1[3]); pw[1][3] = cvtpk_s(O0[14], O0[15]); PIN(pw[1]); PIN(O1); SBAR(); \
    VRD(2); SBAR(); N0 = MF(kf[2], qr[1], N0); O1[4] = EX(O1[4]); O1[5] = EX(O1[5]); pw[2][0] = cvtpk_s(O1[0], O1[1]); PIN(pw[2]); PIN(O1); SBAR(); \
    VRD(3); SBAR(); N1 = MF(kf[3], qr[1], N1); O1[6] = EX(O1[6]); O1[7] = EX(O1[7]); pw[2][1] = cvtpk_s(O1[2], O1[3]); PIN(pw[2]); PIN(O1); SBAR(); \
    VRD(4); SBAR(); N0 = MF(kf[4], qr[2], N0); O1[8] = EX(O1[8]); O1[9] = EX(O1[9]); pw[2][2] = cvtpk_s(O1[4], O1[5]); PIN(pw[2]); PIN(O1); SBAR(); \
    VRD(5); SBAR(); N1 = MF(kf[5], qr[2], N1); O1[10] = EX(O1[10]); O1[11] = EX(O1[11]); pw[2][3] = cvtpk_s(O1[6], O1[7]); PIN(pw[2]); PIN(O1); SBAR(); \
    VRD(6); SBAR(); N0 = MF(kf[6], qr[3], N0); O1[12] = EX(O1[12]); O1[13] = EX(O1[13]); pw[3][0] = cvtpk_s(O1[8], O1[9]); PIN(pw[3]); PIN(O1); SBAR(); \
    VRD(7); SBAR(); N1 = MF(kf[7], qr[3], N1); O1[14] = EX(O1[14]); O1[15] = EX(O1[15]); pw[3][1] = cvtpk_s(O1[10], O1[11]); PIN(pw[3]); PIN(O1); SBAR(); \
    pw[3][2] = cvtpk_s(O1[12], O1[13]); pw[3][3] = cvtpk_s(O1[14], O1[15]); PIN(pw[3]); SBAR(); \
    if (GK) { DMA_K((t) + 3, k3); } if (GV) { DMA_V((t) + VAH, v3); } \
    if (GL) { KRD(0); } SBAR(); ls = MF16(__builtin_bit_cast(bf16x8, pw[0]), onesb, ls); o[0] = MF(__builtin_bit_cast(bf16x8, pw[0]), VFR(0), o[0]); N0[0] = EX(N0[0]); N0[1] = EX(N0[1]); PIN(N0); SBAR(); \
    if (GL) { KRD(1); } SBAR(); o[1] = MF(__builtin_bit_cast(bf16x8, pw[0]), VFR(1), o[1]); N0[2] = EX(N0[2]); N0[3] = EX(N0[3]); PIN(N0); SBAR(); \
    if (GL) { KRD(2); } SBAR(); ls = MF16(__builtin_bit_cast(bf16x8, pw[1]), onesb, ls); o[0] = MF(__builtin_bit_cast(bf16x8, pw[1]), VFR(2), o[0]); N0[4] = EX(N0[4]); N0[5] = EX(N0[5]); pw[0][0] = cvtpk_s(N0[0], N0[1]); PIN(pw[0]); PIN(N0); SBAR(); \
    if (GL) { KRD(3); } SBAR(); o[1] = MF(__builtin_bit_cast(bf16x8, pw[1]), VFR(3), o[1]); N0[6] = EX(N0[6]); N0[7] = EX(N0[7]); pw[0][1] = cvtpk_s(N0[2], N0[3]); PIN(pw[0]); PIN(N0); SBAR(); \
    if (GL) { KRD(4); } SBAR(); ls = MF16(__builtin_bit_cast(bf16x8, pw[2]), onesb, ls); o[0] = MF(__builtin_bit_cast(bf16x8, pw[2]), VFR(4), o[0]); N0[8] = EX(N0[8]); N0[9] = EX(N0[9]); pw[0][2] = cvtpk_s(N0[4], N0[5]); PIN(pw[0]); PIN(N0); SBAR(); \
    if (GL) { KRD(5); } SBAR(); o[1] = MF(__builtin_bit_cast(bf16x8, pw[2]), VFR(5), o[1]); N0[10] = EX(N0[10]); N0[11] = EX(N0[11]); pw[0][3] = cvtpk_s(N0[6], N0[7]); PIN(pw[0]); PIN(N0); SBAR(); \
    if (GL) { KRD(6); } SBAR(); ls = MF16(__builtin_bit_cast(bf16x8, pw[3]), onesb, ls); o[0] = MF(__builtin_bit_cast(bf16x8, pw[3]), VFR(6), o[0]); N0[12] = EX(N0[12]); N0[13] = EX(N0[13]); pw[1][0] = cvtpk_s(N0[8], N0[9]); PIN(pw[1]); PIN(N0); SBAR(); \
    if (GL) { KRD(7); } SBAR(); o[1] = MF(__builtin_bit_cast(bf16x8, pw[3]), VFR(7), o[1]); N0[14] = EX(N0[14]); N0[15] = EX(N0[15]); pw[1][1] = cvtpk_s(N0[10], N0[11]); PIN(pw[1]); PIN(N0); SBAR(); \
  } while (0)

    f32x16 pb0, pb1;
    DMA_K(0, 0); DMA_V(0, 0); DMA_K(1, 1); DMA_K(2, 2); DMA_V(1, 1);
    WB(2 * NPV + 2 * NPK);
    { const int kn_ = 0;
#pragma unroll
      for (int j = 0; j < 8; ++j) KRD(j); }
#pragma unroll
    for (int d0 = 0; d0 < 4; ++d0) {
        if (d0 == 0) { p0 = MF(kf[0], qr[0], negm); p1 = MF(kf[1], qr[0], negm); } else { p0 = MF(kf[2 * d0], qr[d0], p0); p1 = MF(kf[2 * d0 + 1], qr[d0], p1); } }
    if (DV == 64) {
#pragma unroll
      for (int r = 0; r < 16; ++r) p0[r] = EX(p0[r]);
#pragma unroll
      for (int w = 0; w < 6; ++w) pw[w >> 2][w & 3] = cvtpk_s(p0[2 * w], p0[2 * w + 1]);
    } else {
#pragma unroll
      for (int r = 0; r < 16; ++r) { p0[r] = EX(p0[r]); p1[r] = EX(p1[r]); }
#pragma unroll
      for (int w = 0; w < 8; ++w) { pw[w >> 2][w & 3] = cvtpk_s(p0[2 * w], p0[2 * w + 1]); pw[2 + (w >> 2)][w & 3] = cvtpk_s(p1[2 * w], p1[2 * w + 1]); } }
    WB(0);
    DMA_K(3, 3); DMA_V(VAH, 2);
    { const int kn_ = KS;
#pragma unroll
      for (int j = 0; j < 8; ++j) KRD(j); }
    WB(NPK + NPV);
    static_assert(DV == 64, "the generic body is instantiated for the GQA heads only (diff heads: attn_unit_d16)");
    for (int t = 1; t <= NT - 4; t += 4) {
        STEP64D(pb0, pb1, p0, p1, t, true, true, true, 1, 2, 0, 0, 3);     WB(NPK + NPV);
        STEP64D(p0, p1, pb0, pb1, t + 1, true, true, true, 2, 3, 1, 1, 0); WB(NPK + NPV);
        STEP64D(pb0, pb1, p0, p1, t + 2, true, true, true, 3, 0, 2, 2, 1); WB(NPK + NPV);
        STEP64D(p0, p1, pb0, pb1, t + 3, true, true, true, 0, 1, 3, 3, 2); WB(NPK + NPV);
    }
    STEP64D(pb0, pb1, p0, p1, NT - 3, false, true, true, 1, 2, 0, 0, 3);   WB(NPV);
    STEP64D(p0, p1, pb0, pb1, NT - 2, false, false, true, 2, 3, 1, 1, 0);  WB(0);
    STEP64D(pb0, pb1, p0, p1, NT - 1, false, false, false, 3, 0, 2, 2, 1); WB(0);
    if (DV == 64) {
#pragma unroll
      for (int r = 0; r < 16; ++r) pb1[r] = EX(pb1[r]);
      pw[1][2] = cvtpk_s(pb0[12], pb0[13]); pw[1][3] = cvtpk_s(pb0[14], pb0[15]);
#pragma unroll
      for (int w = 0; w < 8; ++w) pw[2 + (w >> 2)][w & 3] = cvtpk_s(pb1[2 * w], pb1[2 * w + 1]);
    }
    { constexpr int vo_ = 3 * VS;
#pragma unroll
      for (int i = 0; i < 4 * ND; ++i) { VRD(i); o[i % ND] = MF(__builtin_bit_cast(bf16x8, pw[i / ND]), VFR(i), o[i % ND]); }
#pragma unroll
      for (int ks = 0; ks < 4; ++ks) ls = MF16(__builtin_bit_cast(bf16x8, pw[ks]), onesb, ls); }
    int lane_e = lane; asm volatile("" : "+v"(lane_e));
    const int r32_e = lane_e & 31, hi_e = lane_e >> 5;
    float* wsf = (float*)(shm + LDS_WSF) + wid * 64;
    { const int c16 = lane_e & 15, rb = 4 * (lane_e >> 4);
      if ((c16 & 7) == 0) {
#pragma unroll
          for (int g = 0; g < 4; ++g) wsf[2 * c16 + rb + g] = ls[g]; } }
    asm volatile("s_waitcnt lgkmcnt(0)\n\ts_barrier" ::: "memory");
    float rli[16];
#pragma unroll
    for (int r = 0; r < 16; ++r) rli[r] = __builtin_amdgcn_rcpf(wsf[crow(r, hi_e)]);
    if (DV == 64) {
        bf16_t* stg = (bf16_t*)shm + wid * 2048;
#pragma unroll
        for (int r = 0; r < 16; ++r) { const int orow = crow(r, hi_e);
#pragma unroll
            for (int d0 = 0; d0 < ND; ++d0) stg[orow * 64 + d0 * 32 + r32_e] = (bf16_t)(cvtpk_s(o[d0][r] * rli[r], 0.f) & 0xffffu); }
        asm volatile("s_waitcnt lgkmcnt(0)" ::: "memory");
#pragma unroll
        for (int i = 0; i < 4; ++i) { const int row = i * 8 + (lane_e >> 3), ch = lane_e & 7; const u32x4 v = *(const u32x4*)(stg + row * 64 + ch * 8); *(u32x4*)(U.Ow + (size_t)row * D + ch * 8) = v; }
    } else {
        float* X = (float*)shm + (wid & 3) * 4096;
        if (wid >= 4) {
#pragma unroll
            for (int r = 0; r < 16; ++r) { const int orow = crow(r, hi_e);
#pragma unroll
                for (int d0 = 0; d0 < ND; ++d0) X[orow * 128 + d0 * 32 + r32_e] = o[d0][r] * rli[r] * lam; }
        }
        asm volatile("s_waitcnt lgkmcnt(0)\n\ts_barrier" ::: "memory");
        if (wid < 4) {
#pragma unroll
            for (int r = 0; r < 16; ++r) { const int orow = crow(r, hi_e);
#pragma unroll
                for (int d0 = 0; d0 < ND; ++d0) { const int a = orow * 128 + d0 * 32 + r32_e; X[a] = o[d0][r] * rli[r] - X[a]; } }
            asm volatile("s_waitcnt lgkmcnt(0)" ::: "memory");
            const int ch = lane_e & 15;
            const f32x4 w0 = *(const f32x4*)(subw + ch * 8), w1 = *(const f32x4*)(subw + ch * 8 + 4);
#pragma unroll
            for (int i = 0; i < 8; ++i) { const int row = i * 4 + (lane_e >> 4);
                const f32x4 v0 = *(const f32x4*)(X + row * 128 + ch * 8), v1 = *(const f32x4*)(X + row * 128 + ch * 8 + 4);
                float ss = v0[0] * v0[0] + v0[1] * v0[1] + v0[2] * v0[2] + v0[3] * v0[3] + v1[0] * v1[0] + v1[1] * v1[1] + v1[2] * v1[2] + v1[3] * v1[3];
                ss += __shfl_xor(ss, 1); ss += __shfl_xor(ss, 2); ss += __shfl_xor(ss, 4); ss += __shfl_xor(ss, 8);
                const float rs = (1.0f - LAMBDA_INIT) / sqrtf(ss * (1.0f / 128.0f) + EPS);
                u32x4 w; w.x = cvtpk_s(v0[0] * rs * w0[0], v0[1] * rs * w0[1]); w.y = cvtpk_s(v0[2] * rs * w0[2], v0[3] * rs * w0[3]);
                w.z = cvtpk_s(v1[0] * rs * w1[0], v1[1] * rs * w1[1]); w.w = cvtpk_s(v1[2] * rs * w1[2], v1[3] * rs * w1[3]);
                *(u32x4*)(U.Ow + (size_t)row * D + ch * 8) = w; }
        }
    }
    asm volatile("s_waitcnt lgkmcnt(0)\n\ts_barrier" ::: "memory");
#undef DMA_K
#undef DMA_V
#undef SBAR
#undef PIN
#undef MF
#undef EX
#undef MF16
#undef VRD
#undef VFR
#undef KRD
#undef KRDC
#undef WB
#undef STEP64
#undef STEP128
#undef STEP64D
}

__device__ __forceinline__ void attn_unit_d16(const UnitDesc& U, char* shm, float lam, const float* subw) {
    constexpr int KS = 16384, VS = 16384, NPK = 2, NPV = 2, NKS = 4, VAH = 2, LDS_K = 0, LDS_V = NKS * KS;
    typedef float f32x4v __attribute__((ext_vector_type(4)));
    const int tid = threadIdx.x, lane = tid & 63, c16 = lane & 15, g = lane >> 4; const int wid = __builtin_amdgcn_readfirstlane(tid >> 6);
    const unsigned lds0 = (unsigned)(uintptr_t)shm;
    const int map = wid >> 2;
    unsigned koff, voff; unsigned kdst[NPK], vdst[NPV];
    { const int key = 8 * wid + (lane >> 3), pp = lane & 7;
      koff = (unsigned)(key * U.KP + (pp ^ ((key >> 1) & 7)) * 8) * 2u; voff = (unsigned)(key * U.VP + ((((pp >> 1) ^ ((key >> 1) & 3)) << 1) + (pp & 1)) * 8) * 2u;
#pragma unroll
      for (int pc = 0; pc < NPK; ++pc) kdst[pc] = lds0 + LDS_K + pc * 8192 + wid * 1024;
#pragma unroll
      for (int pc = 0; pc < NPV; ++pc) vdst[pc] = lds0 + LDS_V + pc * 8192 + wid * 1024; }
#define DMA_K(t, slot) do { _Pragma("unroll") for (int pc_ = 0; pc_ < NPK; ++pc_) glds16s(U.Kt + (size_t)(t) * 64 * U.KP + pc_ * 64, koff, (unsigned)__builtin_amdgcn_readfirstlane(kdst[pc_] + (slot) * KS)); } while (0)
#define DMA_V(t, slot) do { _Pragma("unroll") for (int pc_ = 0; pc_ < NPV; ++pc_) glds16s(U.Vt + (size_t)(t) * 64 * U.VP + pc_ * 64, voff, (unsigned)__builtin_amdgcn_readfirstlane(vdst[pc_] + (slot) * VS)); } while (0)
    const lds_cptr shm3 = (lds_cptr)shm;
    lds_cptr kpb[2];
#pragma unroll
    for (int ds = 0; ds < 2; ++ds) kpb[ds] = shm3 + LDS_K + map * 8192 + c16 * 128 + (((4 * ds + g) ^ (c16 >> 1)) << 4);
    lds_cptr vpb[4];
    { const int q4 = c16 >> 2, p = c16 & 3, ko = 4 * g + q4, swz = (ko >> 1) & 3;
#pragma unroll
      for (int b = 0; b < 4; ++b) vpb[b] = shm3 + LDS_V + ko * 128 + ((b ^ swz) << 5) + p * 8; }
    bf16x8 qr[2][2];
#pragma unroll
    for (int qt = 0; qt < 2; ++qt)
#pragma unroll
        for (int ds = 0; ds < 2; ++ds) qr[qt][ds] = *reinterpret_cast<const bf16x8*>(U.Qw + (size_t)(16 * qt + c16) * 512 + 32 * ds + 8 * g);
    const f32x4v zero4 = {0.f, 0.f, 0.f, 0.f};
    f32x4v o[2][8], S[4][2], ls[2];
#pragma unroll
    for (int qt = 0; qt < 2; ++qt) { ls[qt] = zero4;
#pragma unroll
        for (int dt = 0; dt < 8; ++dt) o[qt][dt] = zero4; }
    const bf16x8 onesb = {(short)0x3F80, (short)0x3F80, (short)0x3F80, (short)0x3F80, (short)0x3F80, (short)0x3F80, (short)0x3F80, (short)0x3F80};
    u32x4 pa[2][2]; bf16x8 kf[4][2]; s16x4 vlo[16], vhi[16];
#define SBAR() __builtin_amdgcn_sched_barrier(0)
#define PIN(x) asm volatile("" : "+v"(x))
#define MF16(a, b, c) __builtin_amdgcn_mfma_f32_16x16x32_bf16(a, b, c, 0, 0, 0)
#define EX(v) __builtin_amdgcn_exp2f(v)
#define VRD16(f) do { vlo[f] = vtr(vpb[(f) & 3] + vo_ + (((f) >> 2) & 1) * 8192 + ((f) >> 3) * 4096); vhi[f] = vtr(vpb[(f) & 3] + vo_ + (((f) >> 2) & 1) * 8192 + ((f) >> 3) * 4096 + 2048); } while (0)
#define VFR16(f) (bf16x8){vlo[f][0], vlo[f][1], vlo[f][2], vlo[f][3], vhi[f][0], vhi[f][1], vhi[f][2], vhi[f][3]}
#define KRD16(j) do { kf[(j) >> 1][(j) & 1] = *(const __attribute__((address_space(3))) bf16x8*)(kpb[(j) & 1] + kn_ + ((j) >> 1) * 2048); } while (0)
#define STEP_D16(t, GK, GV, GL, kq, k1, k3, vq, v3) do { SBAR(); \
    constexpr int vo_ = (vq) * VS, kn_ = (k1) * KS; (void)kn_; \
    SBAR(); S[0][0] = MF16(kf[0][0], qr[0][0], zero4); SBAR(); \
    SBAR(); S[0][0] = MF16(kf[0][1], qr[0][1], S[0][0]); SBAR(); \
    SBAR(); S[0][1] = MF16(kf[0][0], qr[1][0], zero4); SBAR(); \
    SBAR(); S[0][1] = MF16(kf[0][1], qr[1][1], S[0][1]); SBAR(); \
    SBAR(); S[1][0] = MF16(kf[1][0], qr[0][0], zero4); SBAR(); \
    SBAR(); S[1][0] = MF16(kf[1][1], qr[0][1], S[1][0]); SBAR(); \
    SBAR(); S[1][1] = MF16(kf[1][0], qr[1][0], zero4); SBAR(); \
    SBAR(); S[1][1] = MF16(kf[1][1], qr[1][1], S[1][1]); SBAR(); \
    SBAR(); S[2][0] = MF16(kf[2][0], qr[0][0], zero4); SBAR(); \
    SBAR(); S[2][0] = MF16(kf[2][1], qr[0][1], S[2][0]); SBAR(); \
    VRD16(0); SBAR(); S[2][1] = MF16(kf[2][0], qr[1][0], zero4); SBAR(); \
    SBAR(); S[2][1] = MF16(kf[2][1], qr[1][1], S[2][1]); SBAR(); \
    VRD16(1); SBAR(); S[3][0] = MF16(kf[3][0], qr[0][0], zero4); SBAR(); \
    SBAR(); S[3][0] = MF16(kf[3][1], qr[0][1], S[3][0]); SBAR(); \
    VRD16(2); SBAR(); S[3][1] = MF16(kf[3][0], qr[1][0], zero4); SBAR(); \
    SBAR(); S[3][1] = MF16(kf[3][1], qr[1][1], S[3][1]); SBAR(); \
    if (GK) { DMA_K((t) + 3, k3); } if (GV) { DMA_V((t) + VAH, v3); } \
    VRD16(3); SBAR(); ls[0] = MF16(__builtin_bit_cast(bf16x8, pa[0][0]), onesb, ls[0]); o[0][0] = MF16(__builtin_bit_cast(bf16x8, pa[0][0]), VFR16(0), o[0][0]); S[0][0][0] = EX(S[0][0][0]); PIN(S[0][0]); SBAR(); \
    SBAR(); ls[1] = MF16(__builtin_bit_cast(bf16x8, pa[1][0]), onesb, ls[1]); o[1][0] = MF16(__builtin_bit_cast(bf16x8, pa[1][0]), VFR16(0), o[1][0]); S[0][0][1] = EX(S[0][0][1]); PIN(S[0][0]); SBAR(); \
    VRD16(4); SBAR(); o[0][1] = MF16(__builtin_bit_cast(bf16x8, pa[0][0]), VFR16(1), o[0][1]); S[0][0][2] = EX(S[0][0][2]); PIN(S[0][0]); SBAR(); \
    SBAR(); o[1][1] = MF16(__builtin_bit_cast(bf16x8, pa[1][0]), VFR16(1), o[1][1]); S[0][0][3] = EX(S[0][0][3]); PIN(S[0][0]); SBAR(); \
    VRD16(5); SBAR(); o[0][2] = MF16(__builtin_bit_cast(bf16x8, pa[0][0]), VFR16(2), o[0][2]); S[0][1][0] = EX(S[0][1][0]); PIN(S[0][1]); SBAR(); \
    SBAR(); o[1][2] = MF16(__builtin_bit_cast(bf16x8, pa[1][0]), VFR16(2), o[1][2]); S[0][1][1] = EX(S[0][1][1]); PIN(S[0][1]); SBAR(); \
    VRD16(6); SBAR(); o[0][3] = MF16(__builtin_bit_cast(bf16x8, pa[0][0]), VFR16(3), o[0][3]); S[0][1][2] = EX(S[0][1][2]); PIN(S[0][1]); SBAR(); \
    SBAR(); o[1][3] = MF16(__builtin_bit_cast(bf16x8, pa[1][0]), VFR16(3), o[1][3]); S[0][1][3] = EX(S[0][1][3]); PIN(S[0][1]); SBAR(); \
    VRD16(7); SBAR(); o[0][4] = MF16(__builtin_bit_cast(bf16x8, pa[0][0]), VFR16(4), o[0][4]); S[1][0][0] = EX(S[1][0][0]); PIN(S[1][0]); SBAR(); \
    SBAR(); o[1][4] = MF16(__builtin_bit_cast(bf16x8, pa[1][0]), VFR16(4), o[1][4]); S[1][0][1] = EX(S[1][0][1]); PIN(S[1][0]); SBAR(); \
    VRD16(8); SBAR(); o[0][5] = MF16(__builtin_bit_cast(bf16x8, pa[0][0]), VFR16(5), o[0][5]); S[1][0][2] = EX(S[1][0][2]); PIN(S[1][0]); SBAR(); \
    SBAR(); o[1][5] = MF16(__builtin_bit_cast(bf16x8, pa[1][0]), VFR16(5), o[1][5]); S[1][0][3] = EX(S[1][0][3]); PIN(S[1][0]); SBAR(); \
    VRD16(9); SBAR(); o[0][6] = MF16(__builtin_bit_cast(bf16x8, pa[0][0]), VFR16(6), o[0][6]); S[1][1][0] = EX(S[1][1][0]); PIN(S[1][1]); SBAR(); \
    SBAR(); o[1][6] = MF16(__builtin_bit_cast(bf16x8, pa[1][0]), VFR16(6), o[1][6]); S[1][1][1] = EX(S[1][1][1]); PIN(S[1][1]); SBAR(); \
    VRD16(10); SBAR(); o[0][7] = MF16(__builtin_bit_cast(bf16x8, pa[0][0]), VFR16(7), o[0][7]); S[1][1][2] = EX(S[1][1][2]); PIN(S[1][1]); SBAR(); \
    SBAR(); o[1][7] = MF16(__builtin_bit_cast(bf16x8, pa[1][0]), VFR16(7), o[1][7]); S[1][1][3] = EX(S[1][1][3]); PIN(S[1][1]); SBAR(); \
    VRD16(11); if (GL) { KRD16(0); } SBAR(); ls[0] = MF16(__builtin_bit_cast(bf16x8, pa[0][1]), onesb, ls[0]); o[0][0] = MF16(__builtin_bit_cast(bf16x8, pa[0][1]), VFR16(8), o[0][0]); S[2][0][0] = EX(S[2][0][0]); pa[0][0][0] = cvtpk_s(S[0][0][0], S[0][0][1]); PIN(S[2][0]); PIN(pa[0][0]); SBAR(); \
    SBAR(); ls[1] = MF16(__builtin_bit_cast(bf16x8, pa[1][1]), onesb, ls[1]); o[1][0] = MF16(__builtin_bit_cast(bf16x8, pa[1][1]), VFR16(8), o[1][0]); S[2][0][1] = EX(S[2][0][1]); pa[0][0][1] = cvtpk_s(S[0][0][2], S[0][0][3]); PIN(S[2][0]); PIN(pa[0][0]); SBAR(); \
    VRD16(12); if (GL) { KRD16(1); } SBAR(); o[0][1] = MF16(__builtin_bit_cast(bf16x8, pa[0][1]), VFR16(9), o[0][1]); S[2][0][2] = EX(S[2][0][2]); pa[0][0][2] = cvtpk_s(S[1][0][0], S[1][0][1]); PIN(S[2][0]); PIN(pa[0][0]); SBAR(); \
    SBAR(); o[1][1] = MF16(__builtin_bit_cast(bf16x8, pa[1][1]), VFR16(9), o[1][1]); S[2][0][3] = EX(S[2][0][3]); pa[0][0][3] = cvtpk_s(S[1][0][2], S[1][0][3]); PIN(S[2][0]); PIN(pa[0][0]); SBAR(); \
    VRD16(13); if (GL) { KRD16(2); } SBAR(); o[0][2] = MF16(__builtin_bit_cast(bf16x8, pa[0][1]), VFR16(10), o[0][2]); S[2][1][0] = EX(S[2][1][0]); pa[1][0][0] = cvtpk_s(S[0][1][0], S[0][1][1]); PIN(S[2][1]); PIN(pa[1][0]); SBAR(); \
    SBAR(); o[1][2] = MF16(__builtin_bit_cast(bf16x8, pa[1][1]), VFR16(10), o[1][2]); S[2][1][1] = EX(S[2][1][1]); pa[1][0][1] = cvtpk_s(S[0][1][2], S[0][1][3]); PIN(S[2][1]); PIN(pa[1][0]); SBAR(); \
    VRD16(14); if (GL) { KRD16(3); } SBAR(); o[0][3] = MF16(__builtin_bit_cast(bf16x8, pa[0][1]), VFR16(11), o[0][3]); S[2][1][2] = EX(S[2][1][2]); pa[1][0][2] = cvtpk_s(S[1][1][0], S[1][1][1]); PIN(S[2][1]); PIN(pa[1][0]); SBAR(); \
    SBAR(); o[1][3] = MF16(__builtin_bit_cast(bf16x8, pa[1][1]), VFR16(11), o[1][3]); S[2][1][3] = EX(S[2][1][3]); pa[1][0][3] = cvtpk_s(S[1][1][2], S[1][1][3]); PIN(S[2][1]); PIN(pa[1][0]); SBAR(); \
    VRD16(15); if (GL) { KRD16(4); } SBAR(); o[0][4] = MF16(__builtin_bit_cast(bf16x8, pa[0][1]), VFR16(12), o[0][4]); S[3][0][0] = EX(S[3][0][0]); PIN(S[3][0]); SBAR(); \
    SBAR(); o[1][4] = MF16(__builtin_bit_cast(bf16x8, pa[1][1]), VFR16(12), o[1][4]); S[3][0][1] = EX(S[3][0][1]); PIN(S[3][0]); SBAR(); \
    if (GL) { KRD16(5); } SBAR(); o[0][5] = MF16(__builtin_bit_cast(bf16x8, pa[0][1]), VFR16(13), o[0][5]); S[3][0][2] = EX(S[3][0][2]); PIN(S[3][0]); SBAR(); \
    SBAR(); o[1][5] = MF16(__builtin_bit_cast(bf16x8, pa[1][1]), VFR16(13), o[1][5]); S[3][0][3] = EX(S[3][0][3]); PIN(S[3][0]); SBAR(); \
    if (GL) { KRD16(6); } SBAR(); o[0][6] = MF16(__builtin_bit_cast(bf16x8, pa[0][1]), VFR16(14), o[0][6]); S[3][1][0] = EX(S[3][1][0]); PIN(S[3][1]); SBAR(); \
    SBAR(); o[1][6] = MF16(__builtin_bit_cast(bf16x8, pa[1][1]), VFR16(14), o[1][6]); S[3][1][1] = EX(S[3][1][1]); PIN(S[3][1]); SBAR(); \
    if (GL) { KRD16(7); } SBAR(); o[0][7] = MF16(__builtin_bit_cast(bf16x8, pa[0][1]), VFR16(15), o[0][7]); S[3][1][2] = EX(S[3][1][2]); PIN(S[3][1]); SBAR(); \
    SBAR(); o[1][7] = MF16(__builtin_bit_cast(bf16x8, pa[1][1]), VFR16(15), o[1][7]); S[3][1][3] = EX(S[3][1][3]); PIN(S[3][1]); SBAR(); \
    pa[0][1][0] = cvtpk_s(S[2][0][0], S[2][0][1]); pa[0][1][1] = cvtpk_s(S[2][0][2], S[2][0][3]); pa[0][1][2] = cvtpk_s(S[3][0][0], S[3][0][1]); pa[0][1][3] = cvtpk_s(S[3][0][2], S[3][0][3]); pa[1][1][0] = cvtpk_s(S[2][1][0], S[2][1][1]); pa[1][1][1] = cvtpk_s(S[2][1][2], S[2][1][3]); pa[1][1][2] = cvtpk_s(S[3][1][0], S[3][1][1]); pa[1][1][3] = cvtpk_s(S[3][1][2], S[3][1][3]); PIN(pa[0][1]); PIN(pa[1][1]); SBAR(); \
  } while (0)

    DMA_K(0, 0); DMA_V(0, 0); DMA_K(1, 1); DMA_K(2, 2); DMA_V(1, 1);
    ATT_WAIT_BAR(8);
    { const int kn_ = 0;
#pragma unroll
      for (int j = 0; j < 8; ++j) KRD16(j); }
#pragma unroll
    for (int kt = 0; kt < 4; ++kt)
#pragma unroll
        for (int qt = 0; qt < 2; ++qt) { S[kt][qt] = MF16(kf[kt][0], qr[qt][0], zero4); S[kt][qt] = MF16(kf[kt][1], qr[qt][1], S[kt][qt]); }
#pragma unroll
    for (int kt = 0; kt < 4; ++kt)
#pragma unroll
        for (int qt = 0; qt < 2; ++qt)
#pragma unroll
            for (int r = 0; r < 4; ++r) S[kt][qt][r] = EX(S[kt][qt][r]);
#pragma unroll
    for (int qt = 0; qt < 2; ++qt)
#pragma unroll
        for (int ks = 0; ks < 2; ++ks) { pa[qt][ks][0] = cvtpk_s(S[2 * ks][qt][0], S[2 * ks][qt][1]); pa[qt][ks][1] = cvtpk_s(S[2 * ks][qt][2], S[2 * ks][qt][3]);
                                         pa[qt][ks][2] = cvtpk_s(S[2 * ks + 1][qt][0], S[2 * ks + 1][qt][1]); pa[qt][ks][3] = cvtpk_s(S[2 * ks + 1][qt][2], S[2 * ks + 1][qt][3]); }
    ATT_WAIT_BAR(0);
    DMA_K(3, 3); DMA_V(VAH, 2);
    { const int kn_ = KS;
#pragma unroll
      for (int j = 0; j < 8; ++j) KRD16(j); }
    ATT_WAIT_BAR(4);
    for (int t = 1; t <= NT - 4; t += 4) {
        STEP_D16(t, true, true, true, 1, 2, 0, 0, 3);     ATT_WAIT_BAR(4);
        STEP_D16(t + 1, true, true, true, 2, 3, 1, 1, 0); ATT_WAIT_BAR(4);
        STEP_D16(t + 2, true, true, true, 3, 0, 2, 2, 1); ATT_WAIT_BAR(4);
        STEP_D16(t + 3, true, true, true, 0, 1, 3, 3, 2); ATT_WAIT_BAR(4);
    }
    STEP_D16(NT - 3, false, true, true, 1, 2, 0, 0, 3);   ATT_WAIT_BAR(2);
    STEP_D16(NT - 2, false, false, true, 2, 3, 1, 1, 0);  ATT_WAIT_BAR(0);
    STEP_D16(NT - 1, false, false, false, 3, 0, 2, 2, 1); ATT_WAIT_BAR(0);
    { constexpr int vo_ = 3 * VS;
#pragma unroll
      for (int f = 0; f < 16; ++f) { VRD16(f);
#pragma unroll
          for (int qt = 0; qt < 2; ++qt) o[qt][f & 7] = MF16(__builtin_bit_cast(bf16x8, pa[qt][f >> 3]), VFR16(f), o[qt][f & 7]); }
#pragma unroll
      for (int qt = 0; qt < 2; ++qt)
#pragma unroll
          for (int ks = 0; ks < 2; ++ks) ls[qt] = MF16(__builtin_bit_cast(bf16x8, pa[qt][ks]), onesb, ls[qt]); }
    int lane_e = lane; asm volatile("" : "+v"(lane_e));
    const int c16_e = lane_e & 15, g_e = lane_e >> 4;
    asm volatile("s_waitcnt lgkmcnt(0)\n\ts_barrier" ::: "memory");
    float* X = (float*)shm + (wid & 3) * 4096;
    if (wid >= 4) {
#pragma unroll
        for (int qt = 0; qt < 2; ++qt)
#pragma unroll
            for (int r = 0; r < 4; ++r) { const float sc = __builtin_amdgcn_rcpf(ls[qt][r]) * lam; const int row = 16 * qt + 4 * g_e + r;
#pragma unroll
                for (int dt = 0; dt < 8; ++dt) X[row * 128 + 16 * dt + c16_e] = o[qt][dt][r] * sc; }
    }
    asm volatile("s_waitcnt lgkmcnt(0)\n\ts_barrier" ::: "memory");
    if (wid < 4) {
#pragma unroll
        for (int qt = 0; qt < 2; ++qt)
#pragma unroll
            for (int r = 0; r < 4; ++r) { const float sc = __builtin_amdgcn_rcpf(ls[qt][r]); const int row = 16 * qt + 4 * g_e + r;
#pragma unroll
                for (int dt = 0; dt < 8; ++dt) { const int a = row * 128 + 16 * dt + c16_e; X[a] = o[qt][dt][r] * sc - X[a]; } }
        asm volatile("s_waitcnt lgkmcnt(0)" ::: "memory");
        const int ch = lane_e & 15;
        const f32x4 w0 = *(const f32x4*)(subw + ch * 8), w1 = *(const f32x4*)(subw + ch * 8 + 4);
#pragma unroll
        for (int i = 0; i < 8; ++i) { const int row = i * 4 + (lane_e >> 4);
            const f32x4 v0 = *(const f32x4*)(X + row * 128 + ch * 8), v1 = *(const f32x4*)(X + row * 128 + ch * 8 + 4);
            float ss = v0[0] * v0[0] + v0[1] * v0[1] + v0[2] * v0[2] + v0[3] * v0[3] + v1[0] * v1[0] + v1[1] * v1[1] + v1[2] * v1[2] + v1[3] * v1[3];
            ss += __shfl_xor(ss, 1); ss += __shfl_xor(ss, 2); ss += __shfl_xor(ss, 4); ss += __shfl_xor(ss, 8);
            const float rs = (1.0f - LAMBDA_INIT) / sqrtf(ss * (1.0f / 128.0f) + EPS);
            u32x4 w; w.x = cvtpk_s(v0[0] * rs * w0[0], v0[1] * rs * w0[1]); w.y = cvtpk_s(v0[2] * rs * w0[2], v0[3] * rs * w0[3]);
            w.z = cvtpk_s(v1[0] * rs * w1[0], v1[1] * rs * w1[1]); w.w = cvtpk_s(v1[2] * rs * w1[2], v1[3] * rs * w1[3]);
            *(u32x4*)(U.Ow + (size_t)row * D + ch * 8) = w; }
    }
    asm volatile("s_waitcnt lgkmcnt(0)\n\ts_barrier" ::: "memory");
#undef DMA_K
#undef DMA_V
#undef SBAR
#undef PIN
#undef MF16
#undef EX
#undef VRD16
#undef VFR16
#undef KRD16
#undef STEP_D16
}
}
namespace attn {
typedef int i32x8 __attribute__((ext_vector_type(8)));
typedef int i32x4 __attribute__((ext_vector_type(4)));
struct UnitDesc8 {
    const unsigned char* Qw;
    const unsigned char* Kt;
    const unsigned char* Vt;
    bf16_t* Ow; int OP;
};
__device__ __forceinline__ int pk8(int old, float x0, float x1, float x2, float x3) { int w = __builtin_amdgcn_cvt_pk_fp8_f32(x0, x1, old, false); w = __builtin_amdgcn_cvt_pk_fp8_f32(x2, x3, w, true); return w; }

__device__ __forceinline__ void attn_unit_f8(const UnitDesc8& U, char* shm) {
    constexpr int TS = 4096, LDS_K = 0, LDS_V = 4 * TS, VAH = 2;
    const int tid = threadIdx.x, lane = tid & 63, r32 = lane & 31, hi = lane >> 5; const int wid = __builtin_amdgcn_readfirstlane(tid >> 6);
    const unsigned lds0 = (unsigned)(uintptr_t)shm;
    const bool kw = wid < 4; const int piece = wid & 3;
    const unsigned char* dsrc = kw ? U.Kt : U.Vt;
    unsigned dvoff; { const int r = 16 * piece + (lane >> 2), ps = lane & 3; dvoff = (unsigned)(r * 64 + ((ps ^ ((r >> 2) & 3)) << 4)); }
    const unsigned ddst = lds0 + (kw ? LDS_K : LDS_V) + piece * 1024;
    const int dlead = kw ? 3 : VAH;
#define DMA8(t, slot) glds16s(dsrc + (size_t)((t) + dlead) * TS, dvoff, (unsigned)__builtin_amdgcn_readfirstlane(ddst + (slot) * TS))
    const lds_cptr shm3 = (lds_cptr)shm;
    const int sw = (r32 >> 2) & 3;
    const lds_cptr fb0 = shm3 + r32 * 64 + (((2 * hi) ^ sw) << 4), fb1 = shm3 + r32 * 64 + (((2 * hi + 1) ^ sw) << 4);
#define RD16(p, off) (*(const __attribute__((address_space(3))) i32x4*)((p) + (off)))
#define FRAG(dst, off) do { const i32x4 lo_ = RD16(fb0, off), hi_ = RD16(fb1, off); dst = (i32x8){lo_[0], lo_[1], lo_[2], lo_[3], hi_[0], hi_[1], hi_[2], hi_[3]}; } while (0)
    i32x8 qf; { const i32x4 a_ = *(const i32x4*)(U.Qw + r32 * 64 + 32 * hi), b_ = *(const i32x4*)(U.Qw + r32 * 64 + 32 * hi + 16); qf = (i32x8){a_[0], a_[1], a_[2], a_[3], b_[0], b_[1], b_[2], b_[3]}; }
    f32x16 cb = {-4.f, -4.f, -4.f, -4.f, -4.f, -4.f, -4.f, -4.f, -4.f, -4.f, -4.f, -4.f, -4.f, -4.f, -4.f, -4.f};
    i32x8 ones8 = {0x38383838, 0x38383838, 0x38383838, 0x38383838, 0x38383838, 0x38383838, 0x38383838, 0x38383838};
    asm volatile("" : "+v"(cb)); asm volatile("" : "+v"(ones8));
    constexpr int SC1 = 0x7F7F7F7F, SCQ = 0x7C7C7C7C;
#define MFQK(a) __builtin_amdgcn_mfma_scale_f32_32x32x64_f8f6f4(a, qf, cb, 0, 0, 0, SC1, 0, SCQ)
#define MFPV(p, v, c) __builtin_amdgcn_mfma_scale_f32_32x32x64_f8f6f4(p, v, c, 0, 0, 0, SC1, 0, SC1)
    f32x16 o[2] = {f32x16{}, f32x16{}}, ls = f32x16{};
    f32x16 p0, p1, pb0, pb1; i32x8 pfA = {0, 0, 0, 0, 0, 0, 0, 0}, pfB = {0, 0, 0, 0, 0, 0, 0, 0}, kf[2], vf[2];
#define SBAR() __builtin_amdgcn_sched_barrier(0)
#define PIN(x) asm volatile("" : "+v"(x))
#define EX(v) __builtin_amdgcn_exp2f(v)
#define WB(n) do { if ((n) == 0) ATT_WAIT_BAR(0); else if ((n) == 1) ATT_WAIT_BAR(1); else ATT_WAIT_BAR(2); } while (0)
#define STEP_F8(N0, N1, O0, O1, PN, PO, t, GK, GV, GL, k1, k3, vq, v3) do { SBAR(); \
    FRAG(vf[0], LDS_V + (vq) * TS); FRAG(vf[1], LDS_V + (vq) * TS + 2048); SBAR(); \
    N0 = MFQK(kf[0]); \
    O1[4] = EX(O1[4]); O1[5] = EX(O1[5]); O1[6] = EX(O1[6]); O1[7] = EX(O1[7]); O1[8] = EX(O1[8]); O1[9] = EX(O1[9]); PO[3] = pk8(PO[3], O0[12], O0[13], O0[14], O0[15]); PIN(O1); PIN(PO); SBAR(); \
    N1 = MFQK(kf[1]); \
    O1[10] = EX(O1[10]); O1[11] = EX(O1[11]); O1[12] = EX(O1[12]); O1[13] = EX(O1[13]); O1[14] = EX(O1[14]); O1[15] = EX(O1[15]); PO[4] = pk8(PO[4], O1[0], O1[1], O1[2], O1[3]); PO[5] = pk8(PO[5], O1[4], O1[5], O1[6], O1[7]); PIN(O1); PIN(PO); SBAR(); \
    PO[6] = pk8(PO[6], O1[8], O1[9], O1[10], O1[11]); PO[7] = pk8(PO[7], O1[12], O1[13], O1[14], O1[15]); PIN(PO); SBAR(); \
    if (kw ? (GK) : (GV)) DMA8(t, kw ? (k3) : (v3)); \
    if (GL) { FRAG(kf[0], LDS_K + (k1) * TS); FRAG(kf[1], LDS_K + (k1) * TS + 2048); } SBAR(); \
    o[0] = MFPV(PO, vf[0], o[0]); \
    N0[0] = EX(N0[0]); N0[1] = EX(N0[1]); N0[2] = EX(N0[2]); N0[3] = EX(N0[3]); N0[4] = EX(N0[4]); N0[5] = EX(N0[5]); N0[6] = EX(N0[6]); PIN(N0); SBAR(); \
    o[1] = MFPV(PO, vf[1], o[1]); \
    N0[7] = EX(N0[7]); N0[8] = EX(N0[8]); N0[9] = EX(N0[9]); N0[10] = EX(N0[10]); N0[11] = EX(N0[11]); N0[12] = EX(N0[12]); N0[13] = EX(N0[13]); PN[0] = pk8(PN[0], N0[0], N0[1], N0[2], N0[3]); PIN(N0); PIN(PN); SBAR(); \
    ls = MFPV(PO, ones8, ls); \
    N0[14] = EX(N0[14]); N0[15] = EX(N0[15]); N1[0] = EX(N1[0]); N1[1] = EX(N1[1]); N1[2] = EX(N1[2]); N1[3] = EX(N1[3]); PN[1] = pk8(PN[1], N0[4], N0[5], N0[6], N0[7]); PN[2] = pk8(PN[2], N0[8], N0[9], N0[10], N0[11]); PIN(N0); PIN(N1); PIN(PN); SBAR(); \
  } while (0)

    if (kw) { glds16s(dsrc, dvoff, (unsigned)__builtin_amdgcn_readfirstlane(ddst)); glds16s(dsrc + TS, dvoff, (unsigned)__builtin_amdgcn_readfirstlane(ddst + TS)); glds16s(dsrc + 2 * TS, dvoff, (unsigned)__builtin_amdgcn_readfirstlane(ddst + 2 * TS)); }
    else { glds16s(dsrc, dvoff, (unsigned)__builtin_amdgcn_readfirstlane(ddst)); glds16s(dsrc + TS, dvoff, (unsigned)__builtin_amdgcn_readfirstlane(ddst + TS)); }
    WB(2);
    FRAG(kf[0], LDS_K); FRAG(kf[1], LDS_K + 2048);
    p0 = MFQK(kf[0]); p1 = MFQK(kf[1]);
#pragma unroll
    for (int r = 0; r < 16; ++r) p0[r] = EX(p0[r]);
#pragma unroll
    for (int r = 0; r < 4; ++r) p1[r] = EX(p1[r]);
#pragma unroll
    for (int w = 0; w < 3; ++w) pfA[w] = pk8(pfA[w], p0[4 * w], p0[4 * w + 1], p0[4 * w + 2], p0[4 * w + 3]);
    WB(0);
    DMA8(0, kw ? 3 : 2);
    FRAG(kf[0], LDS_K + TS); FRAG(kf[1], LDS_K + TS + 2048);
    WB(1);
    for (int t = 1; t <= NT - 4; t += 4) {
        STEP_F8(pb0, pb1, p0, p1, pfB, pfA, t, true, true, true, 2, 0, 0, 3);     WB(1);
        STEP_F8(p0, p1, pb0, pb1, pfA, pfB, t + 1, true, true, true, 3, 1, 1, 0); WB(1);
        STEP_F8(pb0, pb1, p0, p1, pfB, pfA, t + 2, true, true, true, 0, 2, 2, 1); WB(1);
        STEP_F8(p0, p1, pb0, pb1, pfA, pfB, t + 3, true, true, true, 1, 3, 3, 2); WB(1);
    }
    STEP_F8(pb0, pb1, p0, p1, pfB, pfA, NT - 3, false, true, true, 2, 0, 0, 3);   WB(0);
    STEP_F8(p0, p1, pb0, pb1, pfA, pfB, NT - 2, false, false, true, 3, 1, 1, 0);  WB(0);
    STEP_F8(pb0, pb1, p0, p1, pfB, pfA, NT - 1, false, false, false, 0, 2, 2, 1); WB(0);
#pragma unroll
    for (int r = 4; r < 16; ++r) pb1[r] = EX(pb1[r]);
    pfB[3] = pk8(pfB[3], pb0[12], pb0[13], pb0[14], pb0[15]);
#pragma unroll
    for (int w = 0; w < 4; ++w) pfB[4 + w] = pk8(pfB[4 + w], pb1[4 * w], pb1[4 * w + 1], pb1[4 * w + 2], pb1[4 * w + 3]);
    FRAG(vf[0], LDS_V + 3 * TS); FRAG(vf[1], LDS_V + 3 * TS + 2048);
    o[0] = MFPV(pfB, vf[0], o[0]); o[1] = MFPV(pfB, vf[1], o[1]); ls = MFPV(pfB, ones8, ls);
    int lane_e = lane; asm volatile("" : "+v"(lane_e));
    const int r32_e = lane_e & 31, hi_e = lane_e >> 5;
    asm volatile("s_waitcnt lgkmcnt(0)\n\ts_barrier" ::: "memory");
    bf16_t* stg = (bf16_t*)shm + wid * 2048;
#pragma unroll
    for (int r = 0; r < 16; ++r) { const int orow = crow(r, hi_e); const float rl = __builtin_amdgcn_rcpf(ls[r]);
#pragma unroll
        for (int d0 = 0; d0 < 2; ++d0) stg[orow * 64 + d0 * 32 + r32_e] = (bf16_t)(cvtpk_s(o[d0][r] * rl, 0.f) & 0xffffu); }
    asm volatile("s_waitcnt lgkmcnt(0)" ::: "memory");
#pragma unroll
    for (int i = 0; i < 4; ++i) { const int row = i * 8 + (lane_e >> 3), ch = lane_e & 7; const u32x4 v = *(const u32x4*)(stg + row * 64 + ch * 8); *(u32x4*)(U.Ow + (size_t)row * U.OP + ch * 8) = v; }
    asm volatile("s_waitcnt lgkmcnt(0)\n\ts_barrier" ::: "memory");
#undef DMA8
#undef RD16
#undef FRAG
#undef MFQK
#undef MFPV
#undef SBAR
#undef PIN
#undef EX
#undef WB
#undef STEP_F8
}
}
constexpr int NWAVES = 8;
constexpr int LDS_BYTES = 155648;
#define LAS __attribute__((address_space(3)))
typedef unsigned short bf16;
typedef unsigned v4u __attribute__((ext_vector_type(4)));
typedef float f32x4 __attribute__((ext_vector_type(4)));
typedef float f32x2 __attribute__((ext_vector_type(2)));
__device__ __forceinline__ unsigned f2bf(float f) { unsigned u = __builtin_bit_cast(unsigned, f); return (u + 0x7fffu + ((u >> 16) & 1u)) >> 16; }
__device__ __forceinline__ unsigned pk2(float lo, float hi) { return f2bf(lo) | (f2bf(hi) << 16); }
#define LDS_WAIT() asm volatile("s_waitcnt lgkmcnt(0)" ::: "memory")

#define GAS __attribute__((address_space(1)))
typedef GAS unsigned gu32;
#define XB_TMO      128
#define XB_XCNT(j)  (256  + 64 * (j))
#define XB_XSUB(j)  (1280 + 64 * (j))
#define XB_XGEN(j)  (2304 + 64 * (j))
#define XB_TOP      3328
#define XB_TOPGEN   3392
#define XCD_BAR_WORDS 3456
#define XB_SPIN_CAP (1u << 18)

__device__ __forceinline__ unsigned xb_ld(unsigned* p)              { return __hip_atomic_load(p, __ATOMIC_RELAXED, __HIP_MEMORY_SCOPE_AGENT); }
__device__ __forceinline__ unsigned xb_add(unsigned* p, unsigned v) { return __hip_atomic_fetch_add(p, v, __ATOMIC_RELAXED, __HIP_MEMORY_SCOPE_AGENT); }
__device__ __forceinline__ unsigned xb_xcc_id() { return (unsigned)__builtin_amdgcn_s_getreg((3 << 11) | 20) & 0xFu; }
#define XB_SPIN(cond, bar) do { unsigned _sp = 0; while (cond) { __builtin_amdgcn_s_sleep(1); \
    if ((++_sp & 255u) == 0u) { if (xb_ld(&(bar)[XB_TMO])) break; if (_sp > XB_SPIN_CAP) { atomicAdd(&(bar)[XB_TMO], 1u); break; } } } } while (0)

struct XcdBarrier {
    unsigned* bar; unsigned x;
    volatile LAS unsigned* st;
};

__device__ __forceinline__ XcdBarrier xcd_barrier_post(unsigned* bar, volatile LAS unsigned* st) {
    XcdBarrier b; b.bar = bar; b.x = xb_xcc_id(); b.st = st;
    if (threadIdx.x == 0) (void)xb_add(&bar[XB_XCNT(b.x)], 1u);
    return b;
}
__device__ __forceinline__ void xcd_barrier_complete(unsigned* bar, unsigned x, unsigned& nloc, unsigned& nx) {
    const unsigned G = gridDim.x * gridDim.y * gridDim.z;
    unsigned sum, cnt, mine, sp = 0u;
    for (;;) {
        sum = 0u; cnt = 0u; mine = 0u;
#pragma unroll
        for (unsigned j = 0; j < 16; ++j) { const unsigned c = xb_ld(&bar[XB_XCNT(j)]); sum += c; cnt += (c > 0u) ? 1u : 0u; mine = (j == x) ? c : mine; }
        if (sum == G) break;
        __builtin_amdgcn_s_sleep(1);
        if ((++sp & 255u) == 0u) { if (xb_ld(&bar[XB_TMO])) break; if (sp > XB_SPIN_CAP) { atomicAdd(&bar[XB_TMO], 1u); break; } }
    }
    nloc = mine > 0u ? mine : 1u; nx = cnt > 0u ? cnt : 1u;
}

__device__ __forceinline__ void xcd_barrier(const XcdBarrier& b) {
    asm volatile("s_waitcnt vmcnt(0)" ::: "memory");
    __syncthreads();
    if (threadIdx.x == 0) {
        unsigned* bar = b.bar;
        __builtin_amdgcn_s_waitcnt(0);
        unsigned nloc = b.st[0], nx = b.st[1];
        if (nloc == 0u) { xcd_barrier_complete(bar, b.x, nloc, nx); b.st[0] = nloc; b.st[1] = nx; }
        const unsigned old = xb_add(&bar[XB_XSUB(b.x)], 1u);
        const unsigned gen = old / nloc;
        if (old + 1u == (gen + 1u) * nloc) {
            __builtin_amdgcn_fence(__ATOMIC_RELEASE, "agent");
            asm volatile("s_waitcnt vmcnt(0)" ::: "memory");
            const unsigned og = xb_add(&bar[XB_TOP], 1u);
            const unsigned tg = og / nx;
            if (og + 1u == (tg + 1u) * nx) xb_add(&bar[XB_TOPGEN], 1u);
            else XB_SPIN(xb_ld(&bar[XB_TOPGEN]) == tg, bar);
            __builtin_amdgcn_fence(__ATOMIC_ACQUIRE, "agent");
            xb_add(&bar[XB_XGEN(b.x)], 1u);
            asm volatile("s_waitcnt vmcnt(0)" ::: "memory");
        } else {
            XB_SPIN(xb_ld(&bar[XB_XGEN(b.x)]) == gen, bar);
            __builtin_amdgcn_fence(__ATOMIC_ACQUIRE, "agent");
            asm volatile("s_waitcnt vmcnt(0)" ::: "memory");
        }
    }
    __syncthreads();
}

struct Params {
    const float *xp, *xs, *attn_norm, *w_in, *lq1, *lk1, *lq2, *lk2, *subw, *qnw, *knw, *w_out, *ffn_norm, *wq, *keys, *pu, *pv, *finw;
    float* out; unsigned char* ws; int ph_lo, ph_hi;
};

template <bool WIN>
__device__ __forceinline__ void p0_transpose_item(const float* W, int K, int N, bf16* WT, LAS float* scr, int item, int lane) {
    const int nblk = N / 32, kb = item / nblk, nb = item % nblk, k0 = 64 * kb, n0 = 32 * nb;
#pragma unroll 8
    for (int i = 0; i < 32; ++i) { const int kk = 2 * i + (lane >> 5); scr[kk * 33 + (lane & 31)] = W[(size_t)(k0 + kk) * N + n0 + (lane & 31)]; }
    LDS_WAIT(); asm volatile("" ::: "memory");
    const int c = lane & 7;
#pragma unroll
    for (int j = 0; j < 4; ++j) { const int n = (lane >> 3) + 8 * j; const LAS float* s = scr + (8 * c) * 33 + n;
        v4u o; o.x = pk2(s[0 * 33], s[1 * 33]); o.y = pk2(s[2 * 33], s[3 * 33]); o.z = pk2(s[4 * 33], s[5 * 33]); o.w = pk2(s[6 * 33], s[7 * 33]);
        const int rowo = WIN ? pg8::win_slot_of_col(n0 + n) : (n0 + n);
        *(v4u*)(WT + (size_t)rowo * K + k0 + 8 * c) = o; }
    LDS_WAIT(); asm volatile("" ::: "memory");
}
__device__ __forceinline__ void p0_wk_item(const float* wq, const float* keys, const float* fnw, bf16* WKt, LAS float* lds, int item, int tid) {
    const int hc = item >> 4, k0 = (item & 15) * 64;
    LAS float* wqs = lds;
    LAS float* kys = lds + 64 * 128;
    for (int e = tid; e < 64 * 128; e += 512) { const int kk = e >> 7, d = e & 127; wqs[e] = wq[(size_t)(k0 + kk) * 2048 + hc * 128 + d]; }
    for (int e = tid; e < 128 * 128; e += 512) { const int nn = e >> 7, d = e & 127; kys[nn * 129 + d] = keys[(size_t)(hc * 128 + nn) * 128 + d]; }
    __syncthreads();
    const int nn = tid & 127, kq = tid >> 7;
    float acc[16];
#pragma unroll
    for (int i = 0; i < 16; ++i) acc[i] = 0.f;
    for (int d = 0; d < 128; ++d) { const float kv = kys[nn * 129 + d];
#pragma unroll
        for (int i = 0; i < 16; ++i) acc[i] += wqs[(kq * 16 + i) * 128 + d] * kv; }
    bf16* o = WKt + (size_t)(hc * 128 + nn) * D + k0 + kq * 16;
    const float* fw = fnw + k0 + kq * 16;
    v4u w0, w1;
    w0.x = pk2(acc[0] * fw[0], acc[1] * fw[1]); w0.y = pk2(acc[2] * fw[2], acc[3] * fw[3]); w0.z = pk2(acc[4] * fw[4], acc[5] * fw[5]); w0.w = pk2(acc[6] * fw[6], acc[7] * fw[7]);
    w1.x = pk2(acc[8] * fw[8], acc[9] * fw[9]); w1.y = pk2(acc[10] * fw[10], acc[11] * fw[11]); w1.z = pk2(acc[12] * fw[12], acc[13] * fw[13]); w1.w = pk2(acc[14] * fw[14], acc[15] * fw[15]);
    *(v4u*)o = w0; *(v4u*)(o + 8) = w1;
    __syncthreads();
}
__device__ __forceinline__ f32x2 cs_of(float ang) {
    const double rev = (double)ang * 0.15915494309189533577; const float fr = (float)(rev - floor(rev));
    f32x2 r; r.x = __builtin_amdgcn_cosf(fr); r.y = __builtin_amdgcn_sinf(fr); return r;
}
typedef float f32x2c __attribute__((ext_vector_type(2)));
typedef unsigned v6u __attribute__((ext_vector_type(6)));
typedef unsigned v4u __attribute__((ext_vector_type(4)));
typedef unsigned v2u __attribute__((ext_vector_type(2)));
typedef float v32f __attribute__((ext_vector_type(32)));
typedef int i32x4g __attribute__((ext_vector_type(4)));
constexpr int ROWS6 = 192;
constexpr int SLB = NEXP * ROWS6;
constexpr int SLU = NEXP * 128, NSU = 8, NBU = PEER_NBU;
constexpr int PT = 6;
constexpr int NPB = 4, NQ = 16 / NPB, NB = PEER_NB;
static_assert(NQ % NB == 0 && NB >= 2, "ring");
constexpr int PW_REC = 0, PW_ACT = PT * 512, PW_R = 2 * PT * 512, PW_Y = 2 * PT * 512 + 64, PW_BYTES = PW_Y + PT * 2048;
static_assert(NWAVES * PW_BYTES <= LDS_BYTES - 64, "per-wave PEER scratch does not fit");
struct Row6 { v6u d; };
typedef LAS char* pw_ptr;
struct P16x2 { f32x2c p[16]; };
__device__ __forceinline__ P16x2 peer_cvt6(const Row6& r) { return __builtin_bit_cast(P16x2, __builtin_amdgcn_cvt_scalef32_pk32_f32_fp6(r.d, 1.0f)); }
typedef _Float16 h2g __attribute__((ext_vector_type(2)));
struct H16x2 { h2g p[16]; };
__device__ __forceinline__ H16x2 peer_cvt6h(const Row6& r) { return __builtin_bit_cast(H16x2, __builtin_amdgcn_cvt_scalef32_pk32_f16_fp6(r.d, 1.0f)); }
__device__ __forceinline__ void peer_axpy(const Row6& r, h2g w2, h2g (&acc)[16]) {
    const H16x2 v = peer_cvt6h(r);
#pragma unroll
    for (int k = 0; k < 16; ++k) acc[k] = __builtin_elementwise_fma(w2, v.p[k], acc[k]);
}
template <int N> struct RecT;
template <> struct RecT<4> { typedef i32x4g type; };
template <> struct RecT<2> { typedef int type __attribute__((ext_vector_type(2))); };
template <> struct RecT<8> { typedef int type __attribute__((ext_vector_type(8))); };
typedef RecT<NPB>::type recv_t;
#define PB_RECS(rv, t, q) do { rv = *(const LAS recv_t*)(L + PW_REC + (t) * 512 + (g16 + NPB * (q)) * 4); } while (0)
#define PB_LOAD(buf, T6, rv, soff) do { _Pragma("unroll") for (int i_ = 0; i_ < NPB; ++i_) { \
      int oa_, ob_; asm("v_mad_u32_u16 %0, %1, %2, %3" : "=v"(oa_) : "v"(rv[i_]), "s"(128), "v"(lo16)); asm("v_mad_u32_u16 %0, %1, %2, %3" : "=v"(ob_) : "v"(rv[i_]), "s"(64), "v"(hi8));     \
      const v4u lo_ = __builtin_bit_cast(v4u, __builtin_amdgcn_raw_buffer_load_b128(T6, oa_, soff, 0)); const v2u hi_ = __builtin_bit_cast(v2u, __builtin_amdgcn_raw_buffer_load_b64(T6, ob_, soff, 0)); \
      buf[i_].d = (v6u){lo_[0], lo_[1], lo_[2], lo_[3], hi_[0], hi_[1]}; } } while (0)
__device__ __forceinline__ float sum8(float v) { v += dppf<0xB1>(v); v += dppf<0x4E>(v); v += dppf<0x141>(v); return v; }
template <int CTRL> __device__ __forceinline__ int dppi(int v) { return __builtin_amdgcn_update_dpp(0, v, CTRL, 0xF, 0xF, true); }
#define PB_LOADU(buf, T8, rv, soff) do { _Pragma("unroll") for (int i_ = 0; i_ < 4; ++i_) { \
      int oa_; asm("v_mad_u32_u16 %0, %1, %2, %3" : "=v"(oa_) : "v"(rv[i_]), "s"(128), "v"(lo16)); \
      buf[i_] = __builtin_bit_cast(v4u, __builtin_amdgcn_raw_buffer_load_b128(T8, oa_, soff, 0)); } } while (0)
__device__ __forceinline__ int pb_u_part(const v4u (&buf)[4], const v4u& xq, int m) {
    int d[4];
#pragma unroll
    for (int i = 0; i < 4; ++i) { int a = __builtin_amdgcn_sdot4((int)buf[i][0], (int)xq[0], 0, false); a = __builtin_amdgcn_sdot4((int)buf[i][1], (int)xq[1], a, false);
        a = __builtin_amdgcn_sdot4((int)buf[i][2], (int)xq[2], a, false); d[i] = __builtin_amdgcn_sdot4((int)buf[i][3], (int)xq[3], a, false); }
    const bool b2 = (m & 4) != 0, b1 = (m & 2) != 0;
    const int e0 = (b2 ? d[2] : d[0]) + dppi<0x141>(b2 ? d[0] : d[2]), e1 = (b2 ? d[3] : d[1]) + dppi<0x141>(b2 ? d[1] : d[3]);
    const int f0 = (b1 ? e1 : e0) + dppi<0x4E>(b1 ? e0 : e1);
    return f0 + dppi<0xB1>(f0);
}
typedef unsigned wv_t __attribute__((ext_vector_type(NPB)));
template <bool FIRST>
__device__ __forceinline__ void pb_v_part(const Row6 (&buf)[NPB], const wv_t& rv, h2g (&acc)[16]) {
#pragma unroll
    for (int i = 0; i < NPB; ++i) { Row6 rr = buf[i]; const unsigned wu = rv[i]; const h2g w2 = __builtin_bit_cast(h2g, wu);
        if (FIRST && i == 0) {
            const H16x2 v = peer_cvt6h(rr);
#pragma unroll
            for (int k = 0; k < 16; ++k) acc[k] = w2 * v.p[k];
        } else {
            asm volatile("" : "+v"(rr.d) : "v"(acc[0]), "v"(acc[1]), "v"(acc[2]), "v"(acc[3]), "v"(acc[4]), "v"(acc[5]), "v"(acc[6]), "v"(acc[7]), "v"(acc[8]), "v"(acc[9]), "v"(acc[10]), "v"(acc[11]), "v"(acc[12]), "v"(acc[13]), "v"(acc[14]), "v"(acc[15]));
            peer_axpy(rr, w2, acc); }
        __builtin_amdgcn_sched_barrier(0); }
}
__device__ __forceinline__ h2g hswap_add32(h2g a, h2g b) { auto r = __builtin_amdgcn_permlane32_swap(__builtin_bit_cast(unsigned, a), __builtin_bit_cast(unsigned, b), false, false); return __builtin_bit_cast(h2g, (unsigned)r[0]) + __builtin_bit_cast(h2g, (unsigned)r[1]); }
__device__ __forceinline__ h2g hswap_add16(h2g a, h2g b) { auto r = __builtin_amdgcn_permlane16_swap(__builtin_bit_cast(unsigned, a), __builtin_bit_cast(unsigned, b), false, false); return __builtin_bit_cast(h2g, (unsigned)r[0]) + __builtin_bit_cast(h2g, (unsigned)r[1]); }
__device__ __forceinline__ void peer_block(int tok0, float* X1, const unsigned short* X1B, const int* TKI, const float* TKS, __amdgpu_buffer_rsrc_t U8r, __amdgpu_buffer_rsrc_t V6, const float* USC, const float* VSC,
                                           const float* finw, pw_ptr L, int lane) {
    const int g = lane >> 3, m = lane & 7, g16 = 16 * g, lo16 = 16 * m, hi8 = NEXP * 128 + 8 * m;
    {
        int tia[PT], tib[PT]; v4u xba[PT], xbb[PT];
#pragma unroll
        for (int t = 0; t < PT; ++t) { const size_t tk = (size_t)(tok0 + t); tia[t] = TKI[tk * 128 + lane]; tib[t] = TKI[tk * 128 + 64 + lane];
            const v4u* xb = (const v4u*)(X1B + tk * D + 16 * lane); xba[t] = xb[0]; xbb[t] = xb[1]; }
#pragma unroll
        for (int t = 0; t < PT; ++t) {
            *(LAS int*)(L + PW_REC + t * 512 + lane * 4) = tia[t]; *(LAS int*)(L + PW_REC + t * 512 + 256 + lane * 4) = tib[t];
            *(LAS int*)(L + PW_ACT + t * 512 + lane * 4) = 0; *(LAS int*)(L + PW_ACT + t * 512 + 256 + lane * 4) = 0;
            float ss = 0.f, am = 0.f; float xv[16];
            const v4u xb0 = xba[t], xb1 = xbb[t];
#pragma unroll
            for (int q = 0; q < 4; ++q) { const unsigned w0 = (q < 2) ? xb0[2 * (q & 1)] : xb1[2 * (q & 1)], w1 = (q < 2) ? xb0[2 * (q & 1) + 1] : xb1[2 * (q & 1) + 1];
                const f32x4 a = {__uint_as_float(w0 << 16), __uint_as_float(w0 & 0xffff0000u), __uint_as_float(w1 << 16), __uint_as_float(w1 & 0xffff0000u)};
                ss += a[0] * a[0] + a[1] * a[1] + a[2] * a[2] + a[3] * a[3];
                am = fmaxf(am, fmaxf(fmaxf(fabsf(a[0]), fabsf(a[1])), fmaxf(fabsf(a[2]), fabsf(a[3])))); xv[4 * q] = a[0]; xv[4 * q + 1] = a[1]; xv[4 * q + 2] = a[2]; xv[4 * q + 3] = a[3]; }
            am = row16_max(am); am = fmaxf(am, __shfl_xor(am, 16)); am = fmaxf(am, __shfl_xor(am, 32)); am = fmaxf(am, 1e-30f);
            const float qs = 127.0f / am; v4u xq;
#pragma unroll
            for (int q = 0; q < 4; ++q) { unsigned w = 0u;
#pragma unroll
                for (int j = 0; j < 4; ++j) w |= ((unsigned)(int)rintf(xv[4 * q + j] * qs) & 0xffu) << (8 * j);
                xq[q] = w; }
            *(LAS v4u*)(L + PW_Y + t * 1024 + 16 * lane) = xq;
            const float r = 1.0f / sqrtf(wave_sum(ss) * (1.0f / D) + EPS);
            *(LAS float*)(L + PW_R + t * 8) = r; *(LAS float*)(L + PW_R + t * 8 + 4) = r * am * (1.0f / 127.0f);
        }
    }
    Row6 bb[NB][NPB]; recv_t rv;
    {
        v4u bu[NBU][4]; v4u xq;
#pragma unroll
        for (int q = 0; q < NBU - 1; ++q) { PB_RECS(rv, 0, q); PB_LOADU(bu[q], U8r, rv, 0); }
        for (int it = 0; it < NSU * PT; ++it) {
            const int c = it / PT, t = it - c * PT; const int soff = c * SLU;
            const int itn = it + 1, cn = itn / PT, tn = itn - cn * PT;
            int rq[4];
            xq = *(const LAS v4u*)(L + PW_Y + t * 1024 + 128 * c + 16 * m);
#pragma unroll
            for (int q = 0; q < 4; ++q) {
                const int qa = q + NBU - 1;
                if (qa < 4) { PB_RECS(rv, t, qa); PB_LOADU(bu[qa % NBU], U8r, rv, soff); }
                else if (itn < NSU * PT) { PB_RECS(rv, tn, qa - 4); PB_LOADU(bu[qa % NBU], U8r, rv, cn * SLU); }
                rq[q] = pb_u_part(bu[q % NBU], xq, m);
            }
            LAS int* ap = (LAS int*)(L + PW_ACT + t * 512 + (g16 + 8 * (m & 1) + (m >> 1)) * 4);
            ap[0] += (m & 1) ? rq[2] : rq[0]; ap[4] += (m & 1) ? rq[3] : rq[1];
        }
    }
    {
        float sa[PT], sb[PT], ua[PT], ub[PT], va[PT], vb[PT]; int ia[PT], ib[PT];
#pragma unroll
        for (int t = 0; t < PT; ++t) { const size_t tk = (size_t)(tok0 + t);
            ia[t] = *(const LAS int*)(L + PW_REC + t * 512 + lane * 4); ib[t] = *(const LAS int*)(L + PW_REC + t * 512 + 256 + lane * 4);
            sa[t] = TKS[tk * 128 + lane]; sb[t] = TKS[tk * 128 + 64 + lane]; }
#pragma unroll
        for (int t = 0; t < PT; ++t) { ua[t] = USC[ia[t]]; ub[t] = USC[ib[t]]; va[t] = VSC[ia[t]]; vb[t] = VSC[ib[t]]; }
#pragma unroll
        for (int t = 0; t < PT; ++t) {
            const float r = *(const LAS float*)(L + PW_R + t * 8), rx = *(const LAS float*)(L + PW_R + t * 8 + 4);
            const float s0 = sa[t] * r, s1 = sb[t] * r;
            const float e0 = __expf(s0 - row16_max(s0)), e1 = __expf(s1 - row16_max(s1));
            const float g0 = e0 / row16_sum(e0), g1 = e1 / row16_sum(e1);
            const float a0 = (float)*(const LAS int*)(L + PW_ACT + t * 512 + lane * 4) * rx * ua[t], a1 = (float)*(const LAS int*)(L + PW_ACT + t * 512 + 256 + lane * 4) * rx * ub[t];
            const float w0 = g0 * 0.5f * a0 * (1.0f + erff(a0 * 0.70710678118654752f)) * va[t], w1 = g1 * 0.5f * a1 * (1.0f + erff(a1 * 0.70710678118654752f)) * vb[t];
            { const h2g h0 = {(_Float16)w0, (_Float16)w0}, h1 = {(_Float16)w1, (_Float16)w1};
              *(LAS unsigned*)(L + PW_ACT + t * 512 + lane * 4) = __builtin_bit_cast(unsigned, h0); *(LAS unsigned*)(L + PW_ACT + t * 512 + 256 + lane * 4) = __builtin_bit_cast(unsigned, h1); }
        }
    }
    {
#pragma unroll
        for (int q = 0; q < NB - 1; ++q) { PB_RECS(rv, 0, q); PB_LOAD(bb[q], V6, rv, 0); }
        const bool up = (lane & 8) != 0;
        for (int it = 0; it < 4 * PT; ++it) {
            const int c = it / PT, t = it - c * PT; const int soff = c * SLB;
            const int itn = it + 1, cn = itn / PT, tn = itn - cn * PT;
            h2g acc[16];
#pragma unroll
            for (int q = 0; q < NQ; ++q) {
                const int qa = q + NB - 1;
                if (qa < NQ) { PB_RECS(rv, t, qa); PB_LOAD(bb[qa % NB], V6, rv, soff); }
                else if (itn < 4 * PT) { PB_RECS(rv, tn, qa - NQ); PB_LOAD(bb[qa % NB], V6, rv, cn * SLB); }
                wv_t rw = *(const LAS wv_t*)(L + PW_ACT + t * 512 + (g16 + NPB * q) * 4); if (q == 0) pb_v_part<true>(bb[q % NB], rw, acc); else pb_v_part<false>(bb[q % NB], rw, acc);
            }
            h2g q8[8], q4[4], o2[2];
#pragma unroll
            for (int k = 0; k < 8; ++k) q8[k] = hswap_add32(acc[k], acc[k + 8]);
#pragma unroll
            for (int j = 0; j < 4; ++j) q4[j] = hswap_add16(q8[j], q8[j + 4]);
#pragma unroll
            for (int i = 0; i < 2; ++i) { const h2g keep = up ? q4[i + 2] : q4[i], send = up ? q4[i] : q4[i + 2];
                o2[i] = keep + __builtin_bit_cast(h2g, (unsigned)__builtin_amdgcn_update_dpp(0, (int)__builtin_bit_cast(unsigned, send), 0x128, 0xF, 0xF, true)); }
            *(LAS v2u*)(L + PW_Y + t * 2048 + (256 * c + 32 * m + 4 * g) * 2) = (v2u){__builtin_bit_cast(unsigned, o2[0]), __builtin_bit_cast(unsigned, o2[1])};
        }
    }
    {
        v4u xba[PT], xbb[PT]; f32x4 fw[4];
#pragma unroll
        for (int t = 0; t < PT; ++t) { const v4u* xb = (const v4u*)(X1B + (size_t)(tok0 + t) * D + 16 * lane); xba[t] = xb[0]; xbb[t] = xb[1]; }
#pragma unroll
        for (int q = 0; q < 4; ++q) fw[q] = *(const f32x4*)(finw + 16 * lane + 4 * q);
#pragma unroll
        for (int t = 0; t < PT; ++t) {
            float* xr = X1 + (size_t)(tok0 + t) * D + 16 * lane;
            const v4u xb0 = xba[t], xb1 = xbb[t];
            float x2[16]; float s2 = 0.f;
#pragma unroll
            for (int q = 0; q < 4; ++q) { const unsigned w0 = (q < 2) ? xb0[2 * (q & 1)] : xb1[2 * (q & 1)], w1 = (q < 2) ? xb0[2 * (q & 1) + 1] : xb1[2 * (q & 1) + 1];
                const f32x4 a = {__uint_as_float(w0 << 16), __uint_as_float(w0 & 0xffff0000u), __uint_as_float(w1 << 16), __uint_as_float(w1 & 0xffff0000u)}; const v2u yb = *(const LAS v2u*)(L + PW_Y + t * 2048 + (16 * lane + 4 * q) * 2);
                const unsigned yu0 = yb[0], yu1 = yb[1]; const h2g y0 = __builtin_bit_cast(h2g, yu0), y1 = __builtin_bit_cast(h2g, yu1); const f32x4 y = {(float)y0.x, (float)y0.y, (float)y1.x, (float)y1.y};
                x2[4 * q] = a[0] + y[0]; x2[4 * q + 1] = a[1] + y[1]; x2[4 * q + 2] = a[2] + y[2]; x2[4 * q + 3] = a[3] + y[3];
                s2 += x2[4 * q] * x2[4 * q] + x2[4 * q + 1] * x2[4 * q + 1] + x2[4 * q + 2] * x2[4 * q + 2] + x2[4 * q + 3] * x2[4 * q + 3]; }
            const float r2 = 1.0f / sqrtf(wave_sum(s2) * (1.0f / D) + EPS);
#pragma unroll
            for (int q = 0; q < 4; ++q) { const f32x4 a = fw[q]; f32x4 o; o[0] = x2[4 * q] * r2 * a[0]; o[1] = x2[4 * q + 1] * r2 * a[1]; o[2] = x2[4 * q + 2] * r2 * a[2]; o[3] = x2[4 * q + 3] * r2 * a[3]; *(f32x4*)(xr + 4 * q) = o; }
        }
    }
}
__global__ void __launch_bounds__(NWAVES * 64, 2) mk_fwd(Params P) {
    extern __shared__ __attribute__((aligned(16))) unsigned char lds[];
    cg::grid_group grid = cg::this_grid();
    const int tid = threadIdx.x, lane = tid & 63, wave = __builtin_amdgcn_readfirstlane(tid >> 6);
    const int G = gridDim.x, bx = blockIdx.x, vcu = (G % 8 == 0) ? (bx % 8) * (G / 8) + bx / 8 : bx;
    unsigned char* ws = P.ws;
    bf16* WIN_T = (bf16*)(ws + WS_WIN); bf16* WOUT_T = (bf16*)(ws + WS_WOUT); bf16* WK_T = (bf16*)(ws + WS_WK);
    f32x2* ROPEA = (f32x2*)(ws + WS_ROPEA); f32x2* ROPER = (f32x2*)(ws + WS_ROPER); f32x2* ROPEC = (f32x2*)(ws + WS_ROPEC);
    float* CTL = (float*)(ws + WS_CTL);
    unsigned char* U8 = ws + WS_U16; unsigned char* V8 = ws + WS_V16; float* USC = (float*)(ws + WS_V16 + 16 * MiB); float* VSC = USC + NEXP; bf16* XN = (bf16*)(ws + WS_XN); bf16* ACAT = XN;
    bf16* QA = (bf16*)(ws + WS_QA); bf16* KA = (bf16*)(ws + WS_KA); bf16* VA = (bf16*)(ws + WS_VA); bf16* QB = (bf16*)(ws + WS_QB); bf16* KB = (bf16*)(ws + WS_KB); bf16* VB = (bf16*)(ws + WS_VB);
#ifdef GQA_DEBUG_BUILD
    unsigned char* Q8 = (unsigned char*)(ws + WS_TKI); unsigned char* K8 = (unsigned char*)(ws + WS_TKI + 24 * MiB); unsigned char* V8T = (unsigned char*)(ws + WS_TKI + 30 * MiB);
    bf16* DBG = (bf16*)(ws + WS_QA);
#else
    unsigned char* Q8 = (unsigned char*)(ws + WS_QB); unsigned char* K8 = (unsigned char*)(ws + WS_KB); unsigned char* V8T = (unsigned char*)(ws + WS_VB);
#endif
    bf16* X1B = (bf16*)(ws + WS_X1B); int* TKI = (int*)(ws + WS_TKI); float* TKS = (float*)(ws + WS_TKS);
    const int lo = P.ph_lo, hi = P.ph_hi;
    volatile LAS unsigned* xbst = (volatile LAS unsigned*)((LAS unsigned char*)lds + LDS_BYTES - 16);
    if (tid < 2) xbst[tid] = 0u;
    __syncthreads();
    const XcdBarrier bar = xcd_barrier_post((unsigned*)(ws + WS_BAR), xbst);
#define IN(k) (lo <= (k) && (k) < hi)
#define BOTH(k) (IN(k) && IN((k) + 1))
    if (IN(0)) {
        const int gw = vcu * NWAVES + wave, NGW = G * NWAVES, gt = bx * (NWAVES * 64) + tid, NGT = G * NWAVES * 64;
        for (int it = bx; it < 256; it += G) p0_wk_item(P.wq, P.keys, P.ffn_norm, WK_T, (LAS float*)lds, it, tid);
        { LAS float* scr = (LAS float*)(lds + wave * 16384);
          constexpr int I_IN = (D / 64) * (NCOL / 32), I_OUT = (D / 64) * (D / 32);
          for (int it = gw; it < I_IN + I_OUT; it += NGW) {
              if (it < I_IN) p0_transpose_item<true>(P.w_in, D, NCOL, WIN_T, scr, it, lane);
              else p0_transpose_item<false>(P.w_out, D, D, WOUT_T, scr, it - I_IN, lane);
          } }
        for (int rw = gw; rw < 2 * NEXP; rw += NGW) {
            const bool isv = rw >= NEXP; const int row = isv ? rw - NEXP : rw;
            const float* src = (isv ? P.pv : P.pu) + (size_t)row * D + 16 * lane;
            float v[16]; float am = 0.f;
#pragma unroll
            for (int q = 0; q < 4; ++q) { f32x4 t = *(const f32x4*)(src + 4 * q);
                if (!isv) t = t * *(const f32x4*)(P.ffn_norm + 16 * lane + 4 * q);
                v[4 * q] = t[0]; v[4 * q + 1] = t[1]; v[4 * q + 2] = t[2]; v[4 * q + 3] = t[3];
                am = fmaxf(am, fmaxf(fmaxf(fabsf(t[0]), fabsf(t[1])), fmaxf(fabsf(t[2]), fabsf(t[3])))); }
#pragma unroll
            for (int o = 1; o < 64; o <<= 1) am = fmaxf(am, __shfl_xor(am, o));
            if (!isv) {
                const float a1 = fmaxf(am, 1e-30f), qs = 127.0f / a1; unsigned w4[4];
#pragma unroll
                for (int q = 0; q < 4; ++q) { unsigned w = 0u;
#pragma unroll
                    for (int j = 0; j < 4; ++j) w |= ((unsigned)(int)rintf(v[4 * q + j] * qs) & 0xffu) << (8 * j);
                    w4[q] = w; }
                unsigned* dst = (unsigned*)(U8 + (size_t)(lane >> 3) * NEXP * 128 + (size_t)row * 128 + 16 * (lane & 7));
                dst[0] = w4[0]; dst[1] = w4[1]; dst[2] = w4[2]; dst[3] = w4[3];
                if (lane == 0) USC[row] = a1 * (1.0f / 127.0f);
                continue;
            }
            const float sc = (am > 1e-30f) ? exp2f(floorf(log2f(7.5f / am))) : 1.0f;
            unsigned long long W0 = 0ull; unsigned W1 = 0u;
#pragma unroll
            for (int i = 0; i < 16; ++i) {
                const float y = v[i] * sc, a = fabsf(y);
                float c = (a < 2.0f) ? rintf(a * 8.0f) : ((a < 4.0f) ? 16.0f + rintf((a - 2.0f) * 4.0f) : 24.0f + rintf((a - 4.0f) * 2.0f));
                c = fminf(c, 31.0f);
                const unsigned long long code = (unsigned long long)(((y < 0.f) ? 32u : 0u) | (unsigned)c);
                const int bit = 6 * i;
                if (bit < 64) { W0 |= code << bit; if (bit > 58) W1 |= (unsigned)(code >> (64 - bit)); }
                else W1 |= (unsigned)(code << (bit - 64));
            }
            unsigned char* sl = V8 + (size_t)(lane >> 4) * NEXP * 192;
            unsigned char* sa = sl + (size_t)row * 128; unsigned char* sb = sl + (size_t)NEXP * 128 + (size_t)row * 64;
            const int j8 = (lane >> 1) & 7;
            if ((lane & 1) == 0) { unsigned* dst = (unsigned*)(sa + 16 * j8); dst[0] = (unsigned)W0; dst[1] = (unsigned)(W0 >> 32); dst[2] = W1; }
            else { *(unsigned*)(sa + 16 * j8 + 12) = (unsigned)W0; unsigned* dst = (unsigned*)(sb + 8 * j8); dst[0] = (unsigned)(W0 >> 32); dst[1] = W1; }
            if (lane == 0) VSC[row] = 1.0f / sc;
        }
        for (int i = gt; i < SEQ * 32 + 128 * 16 + 64 * 16; i += NGT) {
            if (i < SEQ * 32) { const int t = i >> 5, k = i & 31; const float inv = (float)pow(10000.0, -(double)(2 * k) / 64.0); ROPEA[i] = cs_of((float)t * inv); }
            else { const int j = i - SEQ * 32; const int pos = (j < 2048) ? (j >> 4) : ((j - 2048) >> 4); const int k = j & 15;
                   const float inv = (float)pow(10000.0, -(double)(2 * k) / 32.0); const f32x2 v = cs_of((float)pos * inv);
                   if (j < 2048) ROPER[j] = v; else ROPEC[j - 2048] = v; }
        }
        { f32x4 wn[4];
#pragma unroll
          for (int j = 0; j < 4; ++j) wn[j] = *((const f32x4*)P.attn_norm + lane + 64 * j);
          for (int m0 = gw * 4; m0 < M; m0 += NGW * 4) {
            f32x4 v[4][4];
#pragma unroll
            for (int q = 0; q < 4; ++q) { const f32x4* xr = (const f32x4*)xrow(P.xp, P.xs, m0 + q) + lane;
#pragma unroll
                for (int j = 0; j < 4; ++j) v[q][j] = xr[64 * j]; }
#pragma unroll
            for (int q = 0; q < 4; ++q) { float s = 0.f;
#pragma unroll
                for (int j = 0; j < 4; ++j) s += (v[q][j][0] * v[q][j][0] + v[q][j][1] * v[q][j][1]) + (v[q][j][2] * v[q][j][2] + v[q][j][3] * v[q][j][3]);
                const float rstd = 1.0f / sqrtf(wave_sum(s) * (1.0f / D) + EPS);
                unsigned long long* o8 = (unsigned long long*)(XN + (size_t)(m0 + q) * D) + lane;
#pragma unroll
                for (int j = 0; j < 4; ++j) o8[64 * j] = (unsigned long long)pk2(v[q][j][0] * rstd * wn[j][0], v[q][j][1] * rstd * wn[j][1]) | ((unsigned long long)pk2(v[q][j][2] * rstd * wn[j][2], v[q][j][3] * rstd * wn[j][3]) << 32); }
          } }
        if (bx == 0 && tid < 128) CTL[tid] = 0.f;
        if (bx == 0 && wave == 2) { float a = P.lq1[lane] * P.lk1[lane], b = P.lq2[lane] * P.lk2[lane]; a = wave_sum(a); b = wave_sum(b); if (lane == 0) CTL[128] = expf(a) - expf(b) + LAMBDA_INIT; }
        if (BOTH(0)) grid.sync();
    }
    if (IN(1)) {
        pg8::Gemm g{XN, WIN_T, M, NCOL, D}; pg8::StaticOrder S; S.init(M, NCOL, G, bx);
        pg8::EpiProj E{QA, KA, VA, QB, KB, VB, (const pg8::f32x2g*)ROPEA, (const pg8::f32x2g*)ROPER, (const pg8::f32x2g*)ROPEC, P.qnw, P.knw, Q8, K8, V8T};
        pg8::gemm_phase<pg8::EpiProj, pg8::StaticOrder, true, true>((LAS unsigned char*)lds, g, S, E);
        if (BOTH(1)) xcd_barrier(bar);
    }
    if (IN(2)) {
        const float lam = CTL[128];
        if (wave >= 4) __builtin_amdgcn_s_setprio(1);
        for (int w0 = vcu; w0 < 12 * 256; w0 += G) {
            const int i0 = w0 >> 8, i = (((i0 ^ w0) & 1) ? 6 : 0) + (i0 >> 1), w = (i << 8) | (w0 & 255);
            const int xcd = (w & 255) >> 5, j = w & 31;
            attn::UnitDesc U;
            if (i < 6) {
                const int pair = 3 * xcd + (i >> 1), seq = pair >> 2, ha = pair & 3, qb = j + 32 * (i & 1);
                const int map = wave >> 2; const size_t r0 = (size_t)seq * SEQ;
                U.Qw = QA + (r0 + qb * 128 + (wave & 3) * 32) * 512 + ha * 128 + map * 64;
                U.Kt = KA + r0 * 512 + ha * 128; U.KP = 512; U.Vt = VA + r0 * 512 + ha * 128; U.VP = 512;
                U.Ow = ACAT + (r0 + qb * 128 + (wave & 3) * 32) * D + ha * 128;
                attn::attn_unit_d16(U, (char*)lds, lam, P.subw);
            } else {
                const int k = i - 6; int pair, un;
                if (k < 4) { pair = xcd; un = j * 4 + k; } else { pair = 8 + (xcd >> 1); un = (xcd & 1) * 64 + j * 2 + (k - 4); }
                const int seq = pair >> 1, kvh = pair & 1, hq = kvh * 4 + (un >> 5), qb = un & 31; const size_t r0 = (size_t)seq * SEQ;
#ifdef GQA_DEBUG_BUILD
                U.Qw = QB + (r0 + qb * 256 + wave * 32) * 512 + hq * 64;
                U.Kt = KB + r0 * 128 + kvh * 64; U.KP = 128; U.Vt = VB + r0 * 128 + kvh * 64; U.VP = 128;
                U.Ow = ACAT + (r0 + qb * 256 + wave * 32) * D + 512 + hq * 64;
                attn::attn_unit<64>(U, (char*)lds, lam, P.subw);
#else
                attn::UnitDesc8 Ud;
                Ud.Qw = Q8 + ((size_t)hq * M + r0 + qb * 256 + wave * 32) * 64;
                Ud.Kt = K8 + ((size_t)kvh * M + r0) * 64; Ud.Vt = V8T + ((size_t)kvh * (M / 64) + (r0 >> 6)) * 4096;
                Ud.Ow = ACAT + (r0 + qb * 256 + wave * 32) * D + 512 + hq * 64; Ud.OP = D;
                attn::attn_unit_f8(Ud, (char*)lds);
#endif
            }
        }
#ifdef GQA_DEBUG_BUILD
        xcd_barrier(bar);
        for (int w = vcu; w < 12 * 256; w += G) {
            const int i = w >> 8, xcd = (w & 255) >> 5, j = w & 31;
            if (i < 6) continue;
            const int k = i - 6; int pair, un;
            if (k < 4) { pair = xcd; un = j * 4 + k; } else { pair = 8 + (xcd >> 1); un = (xcd & 1) * 64 + j * 2 + (k - 4); }
            const int seq = pair >> 1, kvh = pair & 1, hq = kvh * 4 + (un >> 5), qb = un & 31; const size_t r0 = (size_t)seq * SEQ;
            attn::UnitDesc8 Ud;
            Ud.Qw = Q8 + ((size_t)hq * M + r0 + qb * 256 + wave * 32) * 64;
            Ud.Kt = K8 + ((size_t)kvh * M + r0) * 64; Ud.Vt = V8T + ((size_t)kvh * (M / 64) + (r0 >> 6)) * 4096;
            Ud.Ow = DBG + (r0 + qb * 256 + wave * 32) * 512 + hq * 64; Ud.OP = 512;
            attn::attn_unit_f8(Ud, (char*)lds);
        }
        xcd_barrier(bar);
        for (size_t e = (size_t)bx * 512 + tid; e < (size_t)M * 512; e += (size_t)G * 512) {
            const size_t row = e >> 9; const int c = (int)(e & 511);
            const float a = __uint_as_float((unsigned)ACAT[row * D + 512 + c] << 16), b = __uint_as_float((unsigned)DBG[row * 512 + c] << 16);
            ACAT[row * D + 512 + c] = (bf16)(attn::cvtpk_s(a + 10.0f * (b - a), 0.f) & 0xffffu);
        }
#endif
        __builtin_amdgcn_s_setprio(0);
        if (BOTH(2)) xcd_barrier(bar);
    }
    if (IN(3)) {
        pg8::Gemm g{ACAT, WOUT_T, M, D, D}; pg8::StaticOrder S; S.init(M, D, G, bx);
        pg8::EpiResid E{P.xp, P.xs, P.out, X1B};
        pg8::gemm_phase<pg8::EpiResid, pg8::StaticOrder, true, true>((LAS unsigned char*)lds, g, S, E);
        if (BOTH(3)) xcd_barrier(bar);
    }
    if (IN(4)) {
        pg8::Gemm g{X1B, WK_T, M, 2048, D}; pg8::StaticOrder S; S.init(M, 2048, G, bx);
        pg8::EpiTopK E{TKI, TKS};
        for (int i = 0;; ++i) { pg8::Unit u; if (!S.next(i, u)) break; pg8::OneUnit O{u};
            pg8::gemm_phase<pg8::EpiTopK, pg8::OneUnit, false, true>((LAS unsigned char*)lds, g, O, E); }
        if (BOTH(4)) xcd_barrier(bar);
    }
    if (IN(5)) {
        const int gw = vcu * NWAVES + wave, NGW = G * NWAVES;
        const unsigned long long ub_ = (unsigned long long)(uintptr_t)U8, vb_ = (unsigned long long)(uintptr_t)V8;
        const unsigned long long ubu_ = ((unsigned long long)(unsigned)__builtin_amdgcn_readfirstlane((int)(ub_ >> 32)) << 32) | (unsigned)__builtin_amdgcn_readfirstlane((int)ub_);
        const unsigned long long vbu_ = ((unsigned long long)(unsigned)__builtin_amdgcn_readfirstlane((int)(vb_ >> 32)) << 32) | (unsigned)__builtin_amdgcn_readfirstlane((int)vb_);
        const __amdgpu_buffer_rsrc_t U6r = __builtin_amdgcn_make_buffer_rsrc((void*)(uintptr_t)ubu_, 0, NEXP * 1024, 0x00020000), V6r = __builtin_amdgcn_make_buffer_rsrc((void*)(uintptr_t)vbu_, 0, NEXP * 768, 0x00020000);
        pw_ptr L = (pw_ptr)((LAS char*)lds + wave * PW_BYTES);
        for (int tok0 = gw * PT; tok0 < M; tok0 += NGW * PT) peer_block(tok0, P.out, X1B, TKI, TKS, U6r, V6r, USC, VSC, P.finw, L, lane);
    }
#undef IN
#undef BOTH
}
static int mk_grid() {
    static int grid = 0;
    if (grid == 0) {
        int dev = 0, cus = 0, per_cu = 0;
        if (hipGetDevice(&dev) != hipSuccess || hipDeviceGetAttribute(&cus, hipDeviceAttributeMultiprocessorCount, dev) != hipSuccess) { grid = -1; return grid; }
        if (hipFuncSetAttribute((const void*)mk_fwd, hipFuncAttributeMaxDynamicSharedMemorySize, LDS_BYTES) != hipSuccess) { fprintf(stderr, "hipFuncSetAttribute failed\n"); grid = -1; return grid; }
        if (hipOccupancyMaxActiveBlocksPerMultiprocessor(&per_cu, (const void*)mk_fwd, NWAVES * 64, LDS_BYTES) != hipSuccess || per_cu < 1) { fprintf(stderr, "occupancy query: %d\n", per_cu); per_cu = 1; }
        (void)hipGetLastError();
        grid = cus;
    }
    return grid;
}
static void mk_launch(Params& p, int lo, int hi, hipStream_t stream) {
    const int grid = mk_grid(); if (grid <= 0) return;
    p.ph_lo = lo; p.ph_hi = hi;
    void* args[] = {&p};
    hipError_t e = hipLaunchCooperativeKernel((const void*)mk_fwd, dim3(grid), dim3(NWAVES * 64), args, LDS_BYTES, stream);
    if (e != hipSuccess) fprintf(stderr, "cooperative launch failed: %s (grid %d)\n", hipGetErrorString(e), grid);
}
extern "C" void kernel_launch(void* const* d_in, const int* in_sizes, int n_in, void* d_out, int out_size, void* d_ws, size_t ws_size, hipStream_t stream) {
    if (n_in != 18 || ws_size < WS_END) { fprintf(stderr, "kernel_launch: unexpected inputs (n_in %d ws %zu)\n", n_in, ws_size); return; }
    Params p{};
    p.xp = (const float*)d_in[0]; p.xs = (const float*)d_in[1]; p.attn_norm = (const float*)d_in[2]; p.w_in = (const float*)d_in[3];
    p.lq1 = (const float*)d_in[4]; p.lk1 = (const float*)d_in[5]; p.lq2 = (const float*)d_in[6]; p.lk2 = (const float*)d_in[7];
    p.subw = (const float*)d_in[8]; p.qnw = (const float*)d_in[9]; p.knw = (const float*)d_in[10]; p.w_out = (const float*)d_in[11];
    p.ffn_norm = (const float*)d_in[12]; p.wq = (const float*)d_in[13]; p.keys = (const float*)d_in[14]; p.pu = (const float*)d_in[15]; p.pv = (const float*)d_in[16]; p.finw = (const float*)d_in[17];
    p.out = (float*)d_out; p.ws = (unsigned char*)d_ws;
    unsigned char* ws = (unsigned char*)d_ws; float* out = (float*)d_out;
    const float* lam = (const float*)(ws + WS_CTL) + 128;
    if (hipMemsetAsync(ws + WS_BAR, 0, 16384, stream) != hipSuccess) { fprintf(stderr, "memset failed\n"); return; }
    mk_launch(p, 0, 6, stream);
}
```

```cpp
#define PEER_NB 2
#define PEER_NBU 2
#include <hip/hip_runtime.h>
#include <hip/hip_bf16.h>
#include <hip/hip_cooperative_groups.h>
#include <cstdio>
#include <cstdint>
#include <math.h>
namespace cg = cooperative_groups;

constexpr int D = 1024, M = 49152, MP = 16384, SEQ = 8192, NCOL = 2304, NSEQ = 6;
constexpr float EPS = 1e-6f;
constexpr float LAMBDA_INIT = 0.35550906759f;
constexpr float C2 = 0.125f * 1.4426950408889634f;
constexpr int NEXP = 16384;

constexpr size_t MiB = 1u << 20;
constexpr size_t WS_WIN = 0, WS_WOUT = 5 * MiB, WS_WK = 8 * MiB, WS_ROPEA = 12 * MiB, WS_ROPER = 14 * MiB, WS_ROPEC = 14 * MiB + 65536, WS_CTL = 15 * MiB, WS_BAR = 15 * MiB + 65536;
constexpr size_t WS_U16 = 16 * MiB, WS_V16 = 48 * MiB, WS_XN = 80 * MiB  ;
constexpr size_t WS_QA = 176 * MiB, WS_KA = 224 * MiB, WS_VA = 272 * MiB, WS_QB = 320 * MiB, WS_KB = 368 * MiB, WS_VB = 380 * MiB;
constexpr size_t WS_X1B = 176 * MiB  ;
constexpr size_t WS_TKI = 392 * MiB, WS_TKS = 416 * MiB, WS_WG = 440 * MiB, WS_END = 464 * MiB;

__device__ __forceinline__ const float* xrow(const float* xp, const float* xs, int m) { return m < MP ? xp + (size_t)m * D : xs + (size_t)(m - MP) * D; }
template <int CTRL> __device__ __forceinline__ float dppf(float v) { return __uint_as_float((unsigned)__builtin_amdgcn_update_dpp(0, (int)__float_as_uint(v), CTRL, 0xF, 0xF, true)); }
__device__ __forceinline__ float swap_add32(float a, float b) { auto r = __builtin_amdgcn_permlane32_swap(__float_as_uint(a), __float_as_uint(b), false, false); return __uint_as_float(r[0]) + __uint_as_float(r[1]); }
__device__ __forceinline__ float swap_add16(float a, float b) { auto r = __builtin_amdgcn_permlane16_swap(__float_as_uint(a), __float_as_uint(b), false, false); return __uint_as_float(r[0]) + __uint_as_float(r[1]); }
__device__ __forceinline__ float row16_sum(float v) { v += dppf<0xB1>(v); v += dppf<0x4E>(v); v += dppf<0x141>(v); v += dppf<0x140>(v); return v; }
__device__ __forceinline__ float row16_max(float v) { v = fmaxf(v, dppf<0xB1>(v)); v = fmaxf(v, dppf<0x4E>(v)); v = fmaxf(v, dppf<0x141>(v)); v = fmaxf(v, dppf<0x140>(v)); return v; }
__device__ __forceinline__ float wave_sum(float v) { v = row16_sum(v); v = swap_add16(v, v); return swap_add32(v, v); }
namespace pg8 {
#define PG8_LAS __attribute__((address_space(3)))
typedef unsigned short bf16_t;
typedef short bf16x8 __attribute__((ext_vector_type(8)));
typedef float f32x4 __attribute__((ext_vector_type(4)));
typedef unsigned u32x4 __attribute__((ext_vector_type(4)));
constexpr int BM = 256, BK = 64, HALF = 128, HTB = HALF * BK * 2  , STAGE_BYTES = 8 * HTB, NXCD = 8, WGM = 8;

__host__ __device__ __forceinline__ int lds_byte(int r, int c) { const int st = (r >> 4) * 2 + (c >> 5), rr = r & 15, cc = c & 31, ob = rr * 64 + cc * 2; return st * 1024 + (ob ^ (((ob >> 9) & 1) << 5)); }
__host__ __device__ __forceinline__ void stage_rc(int b, int& R, int& C) { const int st = b / 1024, sb = b % 1024, swz = sb ^ (((sb >> 9) & 1) << 5); R = (st >> 1) * 16 + swz / 64; C = (st & 1) * 32 + (swz % 64) / 2; }
__host__ __device__ __forceinline__ int perm32(int rho) { const int n = rho >> 4, i = rho & 15; return 8 * (i >> 2) + 4 * n + (i & 3); }

struct Unit { int pm, pn; };
struct Gemm { const bf16_t* A; const bf16_t* Bt; int M, N, K; };

struct StaticOrder {
    int nM, nN, nwg, G, c;
    __host__ __device__ void init(int M, int N, int G_, int c_) { nM = M / BM; nN = N / BM; nwg = nM * nN; G = G_; c = c_; }
    __host__ __device__ bool next(int i, Unit& u) const {
        const long L = (long)i * G + c; if (L >= nwg) return false;
        int wgid = (int)L; { const int q = nwg / NXCD, r = nwg % NXCD, xcd = wgid % NXCD, off = wgid / NXCD; wgid = (xcd < r ? xcd * (q + 1) : r * (q + 1) + (xcd - r) * q) + off; }
        const int nig = WGM * nN, gid = wgid / nig, fm = gid * WGM, gsz = (nM - fm) < WGM ? (nM - fm) : WGM;
        u.pm = fm + ((wgid % nig) % gsz); u.pn = (wgid % nig) / gsz; return true;
    }
    __device__ __forceinline__ void a_ready(const Unit&) const {}
    __device__ __forceinline__ void done(const Unit&) const {}
};

__device__ __forceinline__ unsigned cvt_pk_bf16(float lo, float hi) { unsigned r; asm volatile("v_cvt_pk_bf16_f32 %0, %1, %2" : "=v"(r) : "v"(lo), "v"(hi)); return r; }
typedef float f32x2 __attribute__((ext_vector_type(2)));
__device__ __forceinline__ f32x2 gelu_pk(f32x2 v) {
    const f32x2 av = __builtin_elementwise_abs(v), d = av * 0.2316418882f + 1.0f;
    f32x2 t; t.x = __builtin_amdgcn_rcpf(d.x); t.y = __builtin_amdgcn_rcpf(d.y);
    f32x2 q = t * 0.5307027145f + (-0.7265760135f); q = q * t + 0.7107068705f; q = q * t + (-0.142248368f); q = q * t + 0.127414796f; q = q * t;
    const f32x2 s = (v * v) * (-0.72134752044f);
    f32x2 e; e.x = __builtin_amdgcn_exp2f(s.x); e.y = __builtin_amdgcn_exp2f(s.y);
    const f32x2 m = v * (q * e), r = v - m;
    f32x2 o; o.x = v.x < 0.f ? m.x : r.x; o.y = v.y < 0.f ? m.y : r.y; return o;
}

template <int ACT  > struct EpiBf16 {
    static constexpr bool PERM = true, AFTER_DRAIN = false; static_assert(ACT == 0 || ACT == 1, "EpiBf16: ACT is 0 (none) or 1 (gelu_pk)");
    bf16_t* O; int ldc; const float* bias; int split_cols; size_t split_stride; float scale0;
    __device__ __forceinline__ void operator()(const f32x4 (&acc)[2][2][4][2], const Unit& u, int wr, int wc, int fr, int fq) const {
        const int row0 = u.pm * BM + wr * 64 + fr; int colt = u.pn * BM; bf16_t* base = O;
        float sc = 1.f; if (split_cols) { const int t = colt / split_cols; base += (size_t)t * split_stride; colt -= t * split_cols; if (t == 0) sc = scale0; }
        const int col0 = colt + wc * 32 + 8 * fq, bcol0 = u.pn * BM + wc * 32 + 8 * fq;
        f32x4 bv[2][2];
#pragma unroll
        for (int bj = 0; bj < 2; ++bj)
#pragma unroll
            for (int n = 0; n < 2; ++n) bv[bj][n] = bias ? *(const f32x4*)(bias + bcol0 + bj * HALF + 4 * n) : (f32x4){0.f, 0.f, 0.f, 0.f};
#pragma unroll
        for (int ai = 0; ai < 2; ++ai)
#pragma unroll
            for (int m = 0; m < 4; ++m) { bf16_t* rowp = base + (size_t)(row0 + ai * HALF + m * 16) * ldc + col0;
#pragma unroll
                for (int bj = 0; bj < 2; ++bj) { f32x4 v0 = acc[ai][bj][m][0] + bv[bj][0], v1 = acc[ai][bj][m][1] + bv[bj][1];
                    if (ACT == 1) { f32x2 a = gelu_pk((f32x2){v0[0], v0[1]}), b = gelu_pk((f32x2){v0[2], v0[3]}), c = gelu_pk((f32x2){v1[0], v1[1]}), d = gelu_pk((f32x2){v1[2], v1[3]});
                        v0 = (f32x4){a.x, a.y, b.x, b.y}; v1 = (f32x4){c.x, c.y, d.x, d.y}; }
                    v0 = v0 * sc; v1 = v1 * sc; u32x4 w; w.x = cvt_pk_bf16(v0[0], v0[1]); w.y = cvt_pk_bf16(v0[2], v0[3]); w.z = cvt_pk_bf16(v1[0], v1[1]); w.w = cvt_pk_bf16(v1[2], v1[3]);
                    *(u32x4*)(rowp + bj * HALF) = w; } }
    }
};
typedef float f32x2g __attribute__((ext_vector_type(2)));
typedef unsigned u32x2 __attribute__((ext_vector_type(2)));
#ifdef GQA_DEBUG_BUILD
constexpr bool GQA_BF16 = true;
#else
constexpr bool GQA_BF16 = false;
#endif
__host__ __device__ __forceinline__ int win_col_of_slot(int pn, int j) {
    const int bj = j >> 7, wc = (j >> 5) & 3, s = j & 31;
    const int base = 256 * pn + 64 * wc;
    const bool axial = (base >= 1536 && base < 2176);
    return axial ? base + 32 * (s >> 4) + 16 * bj + (s & 15) : base + 32 * bj + s;
}
__host__ __device__ __forceinline__ int win_slot_of_col(int n) {
    const int pn = n >> 8, cw = n & 255, wc = cw >> 6, dd = cw & 63;
    const int base = 256 * pn + 64 * wc;
    const bool axial = (base >= 1536 && base < 2176);
    int bj, s;
    if (axial) { const int r = dd >> 5; bj = (dd >> 4) & 1; s = 16 * r + (dd & 15); } else { bj = dd >> 5; s = dd & 31; }
    return 256 * pn + 128 * bj + 32 * wc + s;
}
struct EpiProj {
    static constexpr bool PERM = true, AFTER_DRAIN = false;
    bf16_t *QA, *KA, *VA, *QB, *KB, *VB;
    const f32x2g *ropeA, *ropeR, *ropeC; const float *qnw, *knw;
    unsigned char *Q8, *K8, *V8T;
    static __device__ __forceinline__ unsigned pk8(float x0, float x1, float x2, float x3) { int w = 0; w = __builtin_amdgcn_cvt_pk_fp8_f32(x0, x1, w, false); w = __builtin_amdgcn_cvt_pk_fp8_f32(x2, x3, w, true); return (unsigned)w; }
    __device__ __forceinline__ void operator()(const f32x4 (&acc)[2][2][4][2], const Unit& u, int wr, int wc, int fr, int fq) const {
        const int pn = u.pn;
        int kind, pitch, chunk; bf16_t* dst;
        if (pn < 2) { kind = 0; dst = QA; pitch = 512; chunk = (pn & 1) * 4 + wc; }
        else if (pn < 4) { kind = 1; dst = KA; pitch = 512; chunk = (pn & 1) * 4 + wc; }
        else if (pn < 6) { kind = 2; dst = VA; pitch = 512; chunk = (pn & 1) * 4 + wc; }
        else if (pn < 8) { kind = 3; dst = QB; pitch = 512; chunk = (pn & 1) * 4 + wc; }
        else if (wc < 2) { kind = 4; dst = KB; pitch = 128; chunk = wc; }
        else { kind = 2; dst = VB; pitch = 128; chunk = wc - 2; }
        const float qs = (kind == 0) ? C2 : (kind == 3 && !GQA_BF16) ? 1.4426950408889634f : (kind == 3) ? C2 : 1.0f;
        float wa[8], wb[8];
        if (kind >= 3) { const float* nw = (kind == 3) ? qnw : knw; const int d0 = 32 * (fq >> 1) + 8 * (fq & 1);
#pragma unroll
            for (int e = 0; e < 8; ++e) { wa[e] = nw[d0 + e]; wb[e] = nw[d0 + 16 + e]; } }
#pragma unroll
        for (int ai = 0; ai < 2; ++ai)
#pragma unroll
            for (int m = 0; m < 4; ++m) {
                const int row = u.pm * BM + ai * HALF + wr * 64 + m * 16 + fr, t = row & (SEQ - 1);
                float a[8], b[8];
#pragma unroll
                for (int e = 0; e < 8; ++e) { a[e] = acc[ai][0][m][e >> 2][e & 3]; b[e] = acc[ai][1][m][e >> 2][e & 3]; }
                if (kind != 2) {
                    const f32x2g* tb;
                    if (kind < 2) tb = ropeA + t * 32 + 8 * fq;
                    else {
                        float ss = 0.f;
#pragma unroll
                        for (int e = 0; e < 8; ++e) ss += a[e] * a[e] + b[e] * b[e];
                        ss += __shfl_xor(ss, 16); ss += __shfl_xor(ss, 32);
                        const float rstd = 1.0f / sqrtf(ss * (1.0f / 64.0f) + EPS);
#pragma unroll
                        for (int e = 0; e < 8; ++e) { a[e] *= rstd * wa[e]; b[e] *= rstd * wb[e]; }
                        tb = ((fq >> 1) == 0 ? ropeR + (t >> 6) * 16 : ropeC + (t & 63) * 16) + 8 * (fq & 1);
                    }
#pragma unroll
                    for (int e = 0; e < 8; ++e) { const f32x2g cs = tb[e]; const float oa = a[e] * cs.x - b[e] * cs.y, ob = b[e] * cs.x + a[e] * cs.y; a[e] = oa * qs; b[e] = ob * qs; }
                }
                if (pn >= 6) {
                    const float f8s = (GQA_BF16 && kind == 3) ? 8.0f : 1.0f;
                    if (kind != 2) {
                        unsigned char* p8 = ((kind == 3) ? Q8 : K8) + ((size_t)chunk * M + row) * 64 + 8 * fq;
                        u32x2 wa8, wb8;
                        wa8.x = pk8(a[0] * f8s, a[1] * f8s, a[2] * f8s, a[3] * f8s); wa8.y = pk8(a[4] * f8s, a[5] * f8s, a[6] * f8s, a[7] * f8s);
                        wb8.x = pk8(b[0] * f8s, b[1] * f8s, b[2] * f8s, b[3] * f8s); wb8.y = pk8(b[4] * f8s, b[5] * f8s, b[6] * f8s, b[7] * f8s);
                        *(u32x2*)p8 = wa8; *(u32x2*)(p8 + 32) = wb8;
                    } else {
                        const int k6 = row & 63;
                        unsigned char* p8 = V8T + (((size_t)chunk * (M / 64) + (row >> 6)) * 64 + 8 * fq) * 64 + 32 * ((k6 >> 2) & 1) + 16 * (k6 >> 5) + 4 * ((k6 >> 3) & 3) + (k6 & 3);
                        const unsigned wa0 = pk8(a[0], a[1], a[2], a[3]), wa1 = pk8(a[4], a[5], a[6], a[7]), wb0 = pk8(b[0], b[1], b[2], b[3]), wb1 = pk8(b[4], b[5], b[6], b[7]);
#pragma unroll
                        for (int e = 0; e < 4; ++e) { p8[e * 64] = (unsigned char)(wa0 >> (8 * e)); p8[(4 + e) * 64] = (unsigned char)(wa1 >> (8 * e));
                                                      p8[(32 + e) * 64] = (unsigned char)(wb0 >> (8 * e)); p8[(36 + e) * 64] = (unsigned char)(wb1 >> (8 * e)); }
                    }
                    if (!GQA_BF16) continue;
                }
                bf16_t* p = dst + (size_t)row * pitch + chunk * 64 + 8 * fq;
                u32x4 w0, w1;
                w0.x = cvt_pk_bf16(a[0], a[1]); w0.y = cvt_pk_bf16(a[2], a[3]); w0.z = cvt_pk_bf16(a[4], a[5]); w0.w = cvt_pk_bf16(a[6], a[7]);
                w1.x = cvt_pk_bf16(b[0], b[1]); w1.y = cvt_pk_bf16(b[2], b[3]); w1.z = cvt_pk_bf16(b[4], b[5]); w1.w = cvt_pk_bf16(b[6], b[7]);
                *(u32x4*)p = w0; *(u32x4*)(p + 32) = w1;
            }
    }
};
struct EpiResid {
    static constexpr bool PERM = true, AFTER_DRAIN = false;
    const float *xp, *xs; float* X1; bf16_t* X1B;
    __device__ __forceinline__ void operator()(const f32x4 (&acc)[2][2][4][2], const Unit& u, int wr, int wc, int fr, int fq) const {
#pragma unroll
        for (int ai = 0; ai < 2; ++ai)
#pragma unroll
            for (int m = 0; m < 4; ++m) {
                const int row = u.pm * BM + ai * HALF + wr * 64 + m * 16 + fr;
                const float* xr = xrow(xp, xs, row);
#pragma unroll
                for (int bj = 0; bj < 2; ++bj) {
                    const int col = u.pn * BM + bj * HALF + wc * 32 + 8 * fq;
                    const f32x4 x0 = *(const f32x4*)(xr + col), x1v = *(const f32x4*)(xr + col + 4);
                    const f32x4 v0 = acc[ai][bj][m][0] + x0, v1 = acc[ai][bj][m][1] + x1v;
                    u32x4 w; w.x = cvt_pk_bf16(v0[0], v0[1]); w.y = cvt_pk_bf16(v0[2], v0[3]); w.z = cvt_pk_bf16(v1[0], v1[1]); w.w = cvt_pk_bf16(v1[2], v1[3]);
                    *(u32x4*)(X1B + (size_t)row * D + col) = w;
                }
            }
    }
};
struct OneUnit { Unit u;
    __host__ __device__ bool next(int i, Unit& o) const { if (i != 0) return false; o = u; return true; }
    __device__ __forceinline__ void a_ready(const Unit&) const {}
    __device__ __forceinline__ void done(const Unit&) const {}
};
__device__ __forceinline__ unsigned f2key(float f) { return __float_as_uint(f); }
__device__ __forceinline__ float key2f(unsigned k) { return __uint_as_float(k); }
__device__ __forceinline__ unsigned umax_(unsigned a, unsigned b) { unsigned r; asm("v_max_f32 %0, %1, %2" : "=v"(r) : "v"(a), "v"(b)); return r; }
__device__ __forceinline__ unsigned umin_(unsigned a, unsigned b) { unsigned r; asm("v_min_f32 %0, %1, %2" : "=v"(r) : "v"(a), "v"(b)); return r; }
#define CE(i, j) { const unsigned a_ = k[i], b_ = k[j]; k[i] = umax_(a_, b_); k[j] = umin_(a_, b_); }
__device__ __forceinline__ void sort16_desc(unsigned (&k)[16]) {
    CE(0,1) CE(2,3) CE(0,2) CE(1,3) CE(1,2) CE(4,5) CE(6,7) CE(4,6) CE(5,7) CE(5,6) CE(0,4) CE(2,6) CE(2,4) CE(1,5) CE(3,7) CE(3,5) CE(1,2) CE(3,4) CE(5,6) CE(8,9) CE(10,11) CE(8,10) CE(9,11) CE(9,10) CE(12,13) CE(14,15) CE(12,14) CE(13,15) CE(13,14) CE(8,12) CE(10,14) CE(10,12) CE(9,13) CE(11,15) CE(11,13) CE(9,10) CE(11,12) CE(13,14) CE(0,8) CE(4,12) CE(4,8) CE(2,10) CE(6,14) CE(6,10) CE(2,4) CE(6,8) CE(10,12) CE(1,9) CE(5,13) CE(5,9) CE(3,11) CE(7,15) CE(7,11) CE(3,5) CE(7,9) CE(11,13) CE(1,2) CE(3,4) CE(5,6) CE(7,8) CE(9,10) CE(11,12) CE(13,14)
}
#undef CE
__device__ __forceinline__ void merge16_desc(unsigned (&t)[16], const unsigned (&g)[16]) {
#pragma unroll
    for (int i = 0; i < 16; ++i) t[i] = umax_(t[i], g[15 - i]);
#pragma unroll
    for (int st = 8; st > 0; st >>= 1)
#pragma unroll
        for (int i = 0; i < 16; ++i) { const int l = i ^ st; if (l > i) { const unsigned a = t[i], b = t[l]; t[i] = umax_(a, b); t[l] = umin_(a, b); } }
}
typedef int i32x4e __attribute__((ext_vector_type(4)));
struct EpiTopK {
    static constexpr bool PERM = false, AFTER_DRAIN = true;
    static constexpr int RP = 132, SC_BYTES = 256 * RP * 4, L1_OFF = SC_BYTES;
    int* tki; float* tks;
    __device__ __forceinline__ void fused(f32x4 (&acc)[2][2][4][2], const Unit& u, int wr, int wc, int fr, int fq, PG8_LAS unsigned char* lds, int wid, int lane) const {
        PG8_LAS float* sc = (PG8_LAS float*)lds;
        PG8_LAS unsigned* l1 = (PG8_LAS unsigned*)(lds + L1_OFF);
        const int tid = wid * 64 + lane, h = u.pn;
        PG8_LAS unsigned* scu = (PG8_LAS unsigned*)lds; unsigned tg[2][4];
#pragma unroll
        for (int n = 0; n < 2; ++n)
#pragma unroll
            for (int j = 0; j < 4; ++j) tg[n][j] = (unsigned)(127 - (wc * 32 + n * 16 + fq * 4 + j));
#pragma unroll
        for (int ai = 0; ai < 2; ++ai) {
#pragma unroll
            for (int m = 0; m < 4; ++m)
#pragma unroll
                for (int bj = 0; bj < 2; ++bj)
#pragma unroll
                    for (int n = 0; n < 2; ++n)
#pragma unroll
                        for (int j = 0; j < 4; ++j) scu[(bj * 128 + wc * 32 + n * 16 + fq * 4 + j) * RP + wr * 64 + m * 16 + fr] = (__float_as_uint(acc[ai][bj][m][n][j]) & ~127u) | tg[n][j];
            __syncthreads();
            {
                const int row = tid & 127, c = (tid >> 7) & 1, hh = tid >> 8;
                unsigned T[16], G[16];
                PG8_LAS const unsigned* scp = scu + (c * 128 + 64 * hh) * RP + row;
#pragma unroll
                for (int i = 0; i < 16; ++i) T[i] = scp[i * RP];
                sort16_desc(T);
#pragma unroll 1
                for (int g = 1; g < 4; ++g) {
#pragma unroll
                    for (int i = 0; i < 16; ++i) G[i] = scp[(g * 16 + i) * RP];
                    sort16_desc(G); merge16_desc(T, G);
                }
                __syncthreads();
                PG8_LAS unsigned* hl = (PG8_LAS unsigned*)lds;
#pragma unroll
                for (int i = 0; i < 16; ++i) hl[(hh * 16 + i) * 256 + c * 128 + row] = T[i];
            }
            __syncthreads();
            if (tid < 256) {
                const int row = tid & 127, c = tid >> 7;
                PG8_LAS const unsigned* hl = (PG8_LAS const unsigned*)lds;
                unsigned A[16], B[16];
#pragma unroll
                for (int i = 0; i < 16; ++i) { A[i] = hl[i * 256 + c * 128 + row]; B[i] = hl[(16 + i) * 256 + c * 128 + row]; }
                merge16_desc(A, B);
#pragma unroll
                for (int i = 0; i < 16; ++i) l1[i * 256 + c * 128 + row] = A[i];
            }
            __syncthreads();
            if (tid < 256) {
                const int row = tid & 127, hw = tid >> 7;
                float fa[16], fb[16];
#pragma unroll
                for (int i = 0; i < 16; ++i) { fa[i] = key2f(l1[i * 256 + row] & ~127u); fb[i] = key2f(l1[i * 256 + 128 + row] & ~127u); }
                unsigned T[16], G[16];
                if (hw == 0) { T[0] = (f2key(fa[0] + fb[0]) & ~255u) | 0u; T[1] = (f2key(fa[0] + fb[1]) & ~255u) | 1u; T[2] = (f2key(fa[0] + fb[2]) & ~255u) | 2u; T[3] = (f2key(fa[0] + fb[3]) & ~255u) | 3u; T[4] = (f2key(fa[0] + fb[4]) & ~255u) | 4u; T[5] = (f2key(fa[0] + fb[5]) & ~255u) | 5u; T[6] = (f2key(fa[0] + fb[6]) & ~255u) | 6u; T[7] = (f2key(fa[0] + fb[7]) & ~255u) | 7u; T[8] = (f2key(fa[0] + fb[8]) & ~255u) | 8u; T[9] = (f2key(fa[0] + fb[9]) & ~255u) | 9u; T[10] = (f2key(fa[0] + fb[10]) & ~255u) | 10u; T[11] = (f2key(fa[0] + fb[11]) & ~255u) | 11u; T[12] = (f2key(fa[0] + fb[12]) & ~255u) | 12u; T[13] = (f2key(fa[0] + fb[13]) & ~255u) | 13u; T[14] = (f2key(fa[0] + fb[14]) & ~255u) | 14u; T[15] = (f2key(fa[0] + fb[15]) & ~255u) | 15u; G[0] = (f2key(fa[4] + fb[0]) & ~255u) | 64u; G[1] = (f2key(fa[4] + fb[1]) & ~255u) | 65u; G[2] = (f2key(fa[4] + fb[2]) & ~255u) | 66u; G[3] = (f2key(fa[5] + fb[0]) & ~255u) | 80u; G[4] = (f2key(fa[5] + fb[1]) & ~255u) | 81u; G[5] = (f2key(fa[6] + fb[0]) & ~255u) | 96u; G[6] = (f2key(fa[6] + fb[1]) & ~255u) | 97u; G[7] = (f2key(fa[7] + fb[0]) & ~255u) | 112u; G[8] = (f2key(fa[7] + fb[1]) & ~255u) | 113u; G[9] = 0xFF800000u; G[10] = 0xFF800000u; G[11] = 0xFF800000u; G[12] = 0xFF800000u; G[13] = 0xFF800000u; G[14] = 0xFF800000u; G[15] = 0xFF800000u;     }
                else { T[0] = (f2key(fa[1] + fb[0]) & ~255u) | 16u; T[1] = (f2key(fa[1] + fb[1]) & ~255u) | 17u; T[2] = (f2key(fa[1] + fb[2]) & ~255u) | 18u; T[3] = (f2key(fa[1] + fb[3]) & ~255u) | 19u; T[4] = (f2key(fa[1] + fb[4]) & ~255u) | 20u; T[5] = (f2key(fa[1] + fb[5]) & ~255u) | 21u; T[6] = (f2key(fa[1] + fb[6]) & ~255u) | 22u; T[7] = (f2key(fa[1] + fb[7]) & ~255u) | 23u; T[8] = (f2key(fa[2] + fb[0]) & ~255u) | 32u; T[9] = (f2key(fa[2] + fb[1]) & ~255u) | 33u; T[10] = (f2key(fa[2] + fb[2]) & ~255u) | 34u; T[11] = (f2key(fa[2] + fb[3]) & ~255u) | 35u; T[12] = (f2key(fa[2] + fb[4]) & ~255u) | 36u; T[13] = (f2key(fa[3] + fb[0]) & ~255u) | 48u; T[14] = (f2key(fa[3] + fb[1]) & ~255u) | 49u; T[15] = (f2key(fa[3] + fb[2]) & ~255u) | 50u; G[0] = (f2key(fa[3] + fb[3]) & ~255u) | 51u; G[1] = (f2key(fa[8] + fb[0]) & ~255u) | 128u; G[2] = (f2key(fa[9] + fb[0]) & ~255u) | 144u; G[3] = (f2key(fa[10] + fb[0]) & ~255u) | 160u; G[4] = (f2key(fa[11] + fb[0]) & ~255u) | 176u; G[5] = (f2key(fa[12] + fb[0]) & ~255u) | 192u; G[6] = (f2key(fa[13] + fb[0]) & ~255u) | 208u; G[7] = (f2key(fa[14] + fb[0]) & ~255u) | 224u; G[8] = (f2key(fa[15] + fb[0]) & ~255u) | 240u; G[9] = 0xFF800000u; G[10] = 0xFF800000u; G[11] = 0xFF800000u; G[12] = 0xFF800000u; G[13] = 0xFF800000u; G[14] = 0xFF800000u; G[15] = 0xFF800000u;     }
                sort16_desc(T); sort16_desc(G); merge16_desc(T, G);
                PG8_LAS unsigned* l2 = (PG8_LAS unsigned*)lds;
#pragma unroll
                for (int i = 0; i < 16; ++i) l2[(hw * 16 + i) * 128 + row] = T[i];
            }
            __syncthreads();
            if (tid < 256) {
                const int row = tid & 127, hw = tid >> 7;
                PG8_LAS const unsigned* l2 = (PG8_LAS const unsigned*)lds;
                unsigned T[16], G[16];
#pragma unroll
                for (int i = 0; i < 16; ++i) { T[i] = l2[i * 128 + row]; G[i] = l2[(16 + i) * 128 + row]; }
                merge16_desc(T, G);
                const size_t o = ((size_t)h * M + (size_t)(u.pm * BM + ai * HALF + row)) * 16;
#define TOPK_EMIT8(B_) do { int ix_[8]; float sv_[8]; _Pragma("unroll") for (int k = 0; k < 8; ++k) { \
                        const unsigned code = T[(B_) + k] & 255u; const int i = code >> 4, j = code & 15; \
                        const int i1 = 127 - (int)(l1[i * 256 + row] & 127u), i2 = 127 - (int)(l1[j * 256 + 128 + row] & 127u); \
                        ix_[k] = i1 * 128 + i2; sv_[k] = key2f(T[(B_) + k] & ~255u); } \
                    *(i32x4e*)(tki + o + (B_)) = (i32x4e){ix_[0], ix_[1], ix_[2], ix_[3]}; *(i32x4e*)(tki + o + (B_) + 4) = (i32x4e){ix_[4], ix_[5], ix_[6], ix_[7]}; \
                    *(f32x4*)(tks + o + (B_)) = (f32x4){sv_[0], sv_[1], sv_[2], sv_[3]}; *(f32x4*)(tks + o + (B_) + 4) = (f32x4){sv_[4], sv_[5], sv_[6], sv_[7]}; } while (0)
                if (hw == 0) TOPK_EMIT8(0); else TOPK_EMIT8(8);
#undef TOPK_EMIT8
            }
            __syncthreads();
        }
    }
};
template <class Epi, class Sched, bool ALIGN_EPI = false, bool SP2 = false>
__device__ __forceinline__ void gemm_phase(PG8_LAS unsigned char* lds, const Gemm g, const Sched& S, const Epi& E) {
    const int tid = threadIdx.x, wid = __builtin_amdgcn_readfirstlane(tid >> 6), lane = tid & 63, wr = wid >> 2, wc = wid & 3, fr = lane & 15, fq = lane >> 4;
    const int K = g.K, nt = K / BK;
    unsigned voffA[2], voffB[2];
#pragma unroll
    for (int i = 0; i < 2; ++i) { int R, C; stage_rc(tid * 16 + i * 8192, R, C); const int Rb = Epi::PERM ? ((R & ~31) + perm32(R & 31)) : R;
        voffA[i] = (unsigned)(R * K + C) * 2u; voffB[i] = (unsigned)(Rb * K + C) * 2u; }
    const size_t kstep = (size_t)(BK * 2);
    const size_t hstep = (size_t)HALF * K * 2;
    const size_t tstep = 2 * hstep;
    const unsigned ldsw = (unsigned)wid * 1024u;
    const int aoff = lds_byte(wr * 64 + fr, fq * 8), boff = lds_byte(wc * 32 + fr, fq * 8);
#define PG8_SA(b, h) (((b) * 2 + (h)) * HTB)
#define PG8_SB(b, h) ((4 + (b) * 2 + (h)) * HTB)
#define PG8_STAGE(bufoff, gbase, voff) do { _Pragma("unroll") for (int _i = 0; _i < 2; ++_i) \
        __builtin_amdgcn_global_load_lds((const unsigned*)((const char*)(gbase) + (voff)[_i]), (PG8_LAS unsigned*)(lds + (bufoff) + ldsw + _i * 8192), 16, 0, 0); } while (0)
#define PG8_LDA(dst, b, h) do { _Pragma("unroll") for (int m = 0; m < 4; ++m) _Pragma("unroll") for (int k = 0; k < 2; ++k) dst[m][k] = *(const PG8_LAS bf16x8*)(lds + PG8_SA(b, h) + aoff + m * 2048 + k * 1024); } while (0)
#define PG8_LDB(dst, b, h) do { _Pragma("unroll") for (int n = 0; n < 2; ++n) _Pragma("unroll") for (int k = 0; k < 2; ++k) dst[n][k] = *(const PG8_LAS bf16x8*)(lds + PG8_SB(b, h) + boff + n * 2048 + k * 1024); } while (0)
#define PG8_MMA(ai, bj, At, Bt) do { __builtin_amdgcn_s_setprio(1); _Pragma("unroll") for (int m = 0; m < 4; ++m) _Pragma("unroll") for (int n = 0; n < 2; ++n) _Pragma("unroll") for (int k = 0; k < 2; ++k) \
        acc[ai][bj][m][n] = __builtin_amdgcn_mfma_f32_16x16x32_bf16(Bt[n][k], At[m][k], acc[ai][bj][m][n], 0, 0, 0); __builtin_amdgcn_s_setprio(0); } while (0)
#define PG8_WAIT_V(n) asm volatile("s_waitcnt vmcnt(" #n ")" ::: "memory")
#define PG8_WAIT_L(n) asm volatile("s_waitcnt lgkmcnt(" #n ")" ::: "memory")
#define PG8_BAR __builtin_amdgcn_s_barrier()
#define PG8_SCHED __builtin_amdgcn_sched_barrier(0)
    Unit cur, nxt; int ui = 0;
    if (!S.next(0, cur)) return;
    f32x4 acc[2][2][4][2];
#pragma unroll
    for (int a = 0; a < 2; ++a)
#pragma unroll
        for (int b = 0; b < 2; ++b)
#pragma unroll
            for (int m = 0; m < 4; ++m)
#pragma unroll
                for (int n = 0; n < 2; ++n) acc[a][b][m][n] = (f32x4){0.f, 0.f, 0.f, 0.f};
    bf16x8 At[4][2], B0[2][2], B1[2][2];
    const char* cA = (const char*)g.A + (size_t)cur.pm * tstep; const char* cB = (const char*)g.Bt + (size_t)cur.pn * tstep;
    S.a_ready(cur);
    if constexpr (SP2) {
        PG8_STAGE(PG8_SB(0, 0), cB, voffB); PG8_STAGE(PG8_SB(0, 1), cB + hstep, voffB); PG8_STAGE(PG8_SA(0, 0), cA, voffA); PG8_STAGE(PG8_SA(0, 1), cA + hstep, voffA);
        if (wr == 1) PG8_BAR;
        PG8_WAIT_V(2); PG8_BAR;
        PG8_STAGE(PG8_SB(1, 0), cB + kstep, voffB); PG8_STAGE(PG8_SA(1, 0), cA + kstep, voffA); PG8_STAGE(PG8_SB(1, 1), cB + hstep + kstep, voffB);
        PG8_WAIT_V(6); PG8_BAR;
    } else {
        PG8_STAGE(PG8_SB(0, 0), cB, voffB); PG8_STAGE(PG8_SA(0, 0), cA, voffA); PG8_STAGE(PG8_SB(0, 1), cB + hstep, voffB); PG8_STAGE(PG8_SA(0, 1), cA + hstep, voffA);
        if (wr == 1) PG8_BAR;
        PG8_WAIT_V(4); PG8_BAR;
        PG8_STAGE(PG8_SB(1, 0), cB + kstep, voffB); PG8_STAGE(PG8_SA(1, 0), cA + kstep, voffA); PG8_STAGE(PG8_SB(1, 1), cB + hstep + kstep, voffB);
        PG8_WAIT_V(6); PG8_BAR;
    }
    for (;;) {
        const bool has_next = S.next(ui + 1, nxt);
        const char* nA = has_next ? (const char*)g.A + (size_t)nxt.pm * tstep : cA; const char* nB = has_next ? (const char*)g.Bt + (size_t)nxt.pn * tstep : cB;
        for (int t = 0; t < nt; t += 2) {
            const bool last = (t == nt - 2);
            const char* a1 = cA + (size_t)(t + 1) * kstep;
            const char* a2 = last ? nA : cA + (size_t)(t + 2) * kstep; const char* b2 = last ? nB : cB + (size_t)(t + 2) * kstep;
            const char* a3 = a2 + kstep; const char* b3 = b2 + kstep;
            if (last && has_next) S.a_ready(nxt);
            if constexpr (SP2) {
            PG8_LDB(B0, 0, 0); PG8_LDB(B1, 0, 1); PG8_SCHED; PG8_LDA(At, 0, 0); PG8_STAGE(PG8_SA(1, 1), a1 + hstep, voffA);
            PG8_WAIT_V(8); PG8_WAIT_L(0); PG8_BAR; PG8_MMA(0, 0, At, B0); PG8_MMA(0, 1, At, B1); PG8_BAR; PG8_SCHED;
            PG8_LDA(At, 0, 1); PG8_STAGE(PG8_SB(0, 0), b2, voffB); PG8_STAGE(PG8_SB(0, 1), b2 + hstep, voffB); PG8_STAGE(PG8_SA(0, 0), a2, voffA);
            PG8_WAIT_V(8); PG8_WAIT_L(0); PG8_BAR; PG8_MMA(1, 0, At, B0); PG8_MMA(1, 1, At, B1); PG8_BAR; PG8_SCHED;
            PG8_LDB(B0, 1, 0); PG8_LDB(B1, 1, 1); PG8_SCHED; PG8_LDA(At, 1, 0); PG8_STAGE(PG8_SA(0, 1), a2 + hstep, voffA);
            PG8_WAIT_V(8); PG8_WAIT_L(0); PG8_BAR; PG8_MMA(0, 0, At, B0); PG8_MMA(0, 1, At, B1); PG8_BAR; PG8_SCHED;
            PG8_LDA(At, 1, 1); PG8_STAGE(PG8_SB(1, 0), b3, voffB); PG8_STAGE(PG8_SB(1, 1), b3 + hstep, voffB); PG8_STAGE(PG8_SA(1, 0), a3, voffA);
            PG8_WAIT_V(8); PG8_WAIT_L(0); PG8_BAR; PG8_MMA(1, 0, At, B0); PG8_MMA(1, 1, At, B1); PG8_BAR; PG8_SCHED;
            } else {
            PG8_LDB(B0, 0, 0); PG8_SCHED; PG8_LDA(At, 0, 0); PG8_STAGE(PG8_SA(1, 1), a1 + hstep, voffA);
            PG8_WAIT_L(8); PG8_BAR; PG8_WAIT_L(0); PG8_MMA(0, 0, At, B0); PG8_BAR; PG8_SCHED;
            PG8_LDB(B1, 0, 1); PG8_STAGE(PG8_SB(0, 0), b2, voffB);
            PG8_BAR; PG8_WAIT_L(0); PG8_MMA(0, 1, At, B1); PG8_BAR;
            PG8_LDA(At, 0, 1); PG8_STAGE(PG8_SA(0, 0), a2, voffA);
            PG8_BAR; PG8_WAIT_L(0); PG8_MMA(1, 0, At, B0); PG8_BAR; PG8_SCHED;
            PG8_STAGE(PG8_SB(0, 1), b2 + hstep, voffB);
            PG8_WAIT_V(6); PG8_BAR; PG8_MMA(1, 1, At, B1); PG8_BAR;
            PG8_LDB(B0, 1, 0); PG8_SCHED; PG8_LDA(At, 1, 0); PG8_STAGE(PG8_SA(0, 1), a2 + hstep, voffA);
            PG8_WAIT_L(8); PG8_BAR; PG8_WAIT_L(0); PG8_MMA(0, 0, At, B0); PG8_BAR; PG8_SCHED;
            PG8_LDB(B1, 1, 1); PG8_STAGE(PG8_SB(1, 0), b3, voffB);
            PG8_BAR; PG8_WAIT_L(0); PG8_MMA(0, 1, At, B1); PG8_BAR;
            PG8_LDA(At, 1, 1); PG8_STAGE(PG8_SA(1, 0), a3, voffA);
            PG8_BAR; PG8_WAIT_L(0); PG8_MMA(1, 0, At, B0); PG8_BAR; PG8_SCHED;
            PG8_STAGE(PG8_SB(1, 1), b3 + hstep, voffB);
            PG8_WAIT_V(6); PG8_BAR; PG8_MMA(1, 1, At, B1); PG8_BAR;
            }
        }
        if constexpr (ALIGN_EPI) { if (wr == 0) PG8_BAR; }
        if constexpr (!Epi::AFTER_DRAIN) { E(acc, cur, wr, wc, fr, fq); S.done(cur); }
        if (!has_next) break;
#pragma unroll
        for (int a = 0; a < 2; ++a)
#pragma unroll
            for (int b = 0; b < 2; ++b)
#pragma unroll
                for (int m = 0; m < 4; ++m)
#pragma unroll
                    for (int n = 0; n < 2; ++n) acc[a][b][m][n] = (f32x4){0.f, 0.f, 0.f, 0.f};
        cur = nxt; cA = nA; cB = nB; ++ui;
        if constexpr (ALIGN_EPI) { if (wr == 1) PG8_BAR; }
    }
    PG8_WAIT_V(0);
    if constexpr (!ALIGN_EPI) { if (wr == 0) PG8_BAR; }
    PG8_BAR;
    if constexpr (Epi::AFTER_DRAIN) { E.fused(acc, cur, wr, wc, fr, fq, lds, wid, lane); S.done(cur); }
#undef PG8_SA
#undef PG8_SB
#undef PG8_STAGE
#undef PG8_LDA
#undef PG8_LDB
#undef PG8_MMA
#undef PG8_WAIT_V
#undef PG8_WAIT_L
#undef PG8_BAR
#undef PG8_SCHED
}
}
namespace attn {
typedef unsigned short bf16_t;
using bf16x8 = __attribute__((ext_vector_type(8))) short;
using s16x4 = __attribute__((ext_vector_type(4))) short;
using f32x16 = __attribute__((ext_vector_type(16))) float;
using f32x4 = __attribute__((ext_vector_type(4))) float;
using u32x4 = __attribute__((ext_vector_type(4))) unsigned;
typedef __attribute__((address_space(3))) const char* lds_cptr;
typedef __attribute__((address_space(3))) char* lds_ptr;
typedef short v4i16_t __attribute__((ext_vector_type(4)));
typedef float f32x2_t __attribute__((ext_vector_type(2))); typedef __bf16 bf16x2_t __attribute__((ext_vector_type(2)));
constexpr int NT = SEQ / 64;
constexpr int LDS_WSF = 9 * 16384;
constexpr int ATTN_LDS_BYTES = LDS_WSF + 8 * 256;
__device__ __forceinline__ int crow(int r, int hi) { return (r & 3) + 8 * (r >> 2) + 4 * hi; }
__device__ __forceinline__ unsigned cvtpk_s(float lo, float hi) { f32x2_t v = {lo, hi}; bf16x2_t b = __builtin_convertvector(v, bf16x2_t); return __builtin_bit_cast(unsigned, b); }
__device__ __forceinline__ void glds16(const void* gsrc, unsigned lds_dst) { unsigned keep;
    asm volatile("s_mov_b32 %0, m0\n\ts_mov_b32 m0, %2\n\ts_nop 0\n\tglobal_load_lds_dwordx4 %1, off\n\ts_mov_b32 m0, %0" : "=&s"(keep) : "v"(gsrc), "s"(lds_dst) : "memory"); }
__device__ __forceinline__ void glds16s(const void* sbase, unsigned voff, unsigned lds_dst) { unsigned keep;
    asm volatile("s_mov_b32 %0, m0\n\ts_mov_b32 m0, %3\n\ts_nop 0\n\tglobal_load_lds_dwordx4 %1, %2\n\ts_mov_b32 m0, %0" : "=&s"(keep) : "v"(voff), "s"(sbase), "s"(lds_dst) : "memory"); }
__device__ __forceinline__ s16x4 vtr(lds_cptr p) { return __builtin_bit_cast(s16x4, __builtin_amdgcn_ds_read_tr16_b64_v4i16((__attribute__((address_space(3))) v4i16_t*)p)); }
__device__ __forceinline__ float fadd_s(float a, float b) { float r; asm("v_add_f32_e32 %0, %1, %2" : "=v"(r) : "v"(a), "v"(b)); return r; }
__device__ __forceinline__ float bf2f(short s) { return __uint_as_float(((unsigned)(unsigned short)s) << 16); }
#define ATT_WAIT_BAR(N) asm volatile("s_waitcnt vmcnt(" #N ") lgkmcnt(0)\n\ts_barrier" ::: "memory")
#define ATT_WAIT_BARV(N) asm volatile("s_waitcnt vmcnt(" #N ")\n\ts_barrier" ::: "memory")

struct UnitDesc {
    const bf16_t* Qw;
    const bf16_t* Kt; int KP;
    const bf16_t* Vt; int VP;
    bf16_t* Ow;
};

template <int DV>
__device__ __forceinline__ void attn_unit(const UnitDesc& U, char* shm, float lam, const float* subw) {
    constexpr int KCH = (DV == 64) ? 8 : 16, KS = KCH * 1024, ND = DV / 32, VS = ND * 4096, NPK = KCH / 8, NPV = ND / 2;
    constexpr int NKS = 4, VAH = 2, NVS = 4; constexpr int LDS_K = 0, LDS_V = NKS * KS;
    const int tid = threadIdx.x, lane = tid & 63, r32 = lane & 31, hi = lane >> 5; const int wid = __builtin_amdgcn_readfirstlane(tid >> 6);
    const unsigned lds0 = (unsigned)(uintptr_t)shm;
    const int map = (DV == 128) ? (wid >> 2) : 0;
    unsigned koff, voff; unsigned kdst[NPK], vdst[NPV];
    { const int key = 8 * wid + (lane >> 3), pp = lane & 7;
      koff = (unsigned)(key * U.KP + (pp ^ ((key >> 1) & 7)) * 8) * 2u; voff = (unsigned)(key * U.VP + ((((pp >> 2) ^ ((key >> 1) & 1)) << 2) + (pp & 3)) * 8) * 2u;
#pragma unroll
      for (int pc = 0; pc < NPK; ++pc) kdst[pc] = lds0 + LDS_K + pc * 8192 + wid * 1024;
#pragma unroll
      for (int pc = 0; pc < NPV; ++pc) vdst[pc] = lds0 + LDS_V + pc * 8192 + wid * 1024; }
#define DMA_K(t, slot) do { _Pragma("unroll") for (int pc_ = 0; pc_ < NPK; ++pc_) glds16s(U.Kt + (size_t)(t) * 64 * U.KP + pc_ * 64, koff, (unsigned)__builtin_amdgcn_readfirstlane(kdst[pc_] + (slot) * KS)); } while (0)
#define DMA_V(t, slot) do { _Pragma("unroll") for (int pc_ = 0; pc_ < NPV; ++pc_) glds16s(U.Vt + (size_t)(t) * 64 * U.VP + pc_ * 64, voff, (unsigned)__builtin_amdgcn_readfirstlane(vdst[pc_] + (slot) * VS)); } while (0)
    const lds_cptr shm3 = (lds_cptr)shm;
    lds_cptr kpb[4];
#pragma unroll
    for (int d0 = 0; d0 < 4; ++d0) kpb[d0] = shm3 + LDS_K + map * 8192 + r32 * 128 + (((2 * d0 + hi) ^ ((r32 >> 1) & 7)) << 4);
    lds_cptr vpb[2];
    { const int q4 = (lane & 15) >> 2, swz = (q4 >> 1) & 1;
#pragma unroll
      for (int h = 0; h < 2; ++h) vpb[h] = shm3 + LDS_V + (4 * hi + q4) * 128 + ((h ^ swz) << 6) + ((lane >> 4) & 1) * 32 + (lane & 3) * 8; }
    bf16x8 qr[4];
#pragma unroll
    for (int d0 = 0; d0 < 4; ++d0) qr[d0] = *reinterpret_cast<const bf16x8*>(U.Qw + (size_t)r32 * 512 + d0 * 16 + hi * 8);
    const f32x16 negm = f32x16{};
    f32x16 o[ND];
#pragma unroll
    for (int d = 0; d < ND; ++d) o[d] = f32x16{};
    f32x4 ls = {0.f, 0.f, 0.f, 0.f};
    const short one_ = (((lane >> 4) & 1) == ((lane & 15) >> 3)) ? (short)0x3F80 : (short)0;
    const bf16x8 onesb = {one_, one_, one_, one_, one_, one_, one_, one_};
    f32x16 p0, p1; u32x4 pw[4]; bf16x8 kf[8]; s16x4 vlo[4 * ND], vhi[4 * ND];
#define SBAR() __builtin_amdgcn_sched_barrier(0)
#define PIN(x) asm volatile("" : "+v"(x))
#define MF(a, b, c) __builtin_amdgcn_mfma_f32_32x32x16_bf16(a, b, c, 0, 0, 0)
#define EX(v) __builtin_amdgcn_exp2f(v)
#define MF16(a, b, c) __builtin_amdgcn_mfma_f32_16x16x32_bf16(a, b, c, 0, 0, 0)
#define VRD(i) do { vlo[i] = vtr(vpb[((i) % ND) & 1] + vo_ + (((i) % ND) >> 1) * 8192 + ((i) / ND) * 2048); vhi[i] = vtr(vpb[((i) % ND) & 1] + vo_ + (((i) % ND) >> 1) * 8192 + ((i) / ND) * 2048 + 1024); } while (0)
#define VFR(i) (bf16x8){vlo[i][0], vlo[i][1], vlo[i][2], vlo[i][3], vhi[i][0], vhi[i][1], vhi[i][2], vhi[i][3]}
#define KRD(j) do { kf[j] = *(const __attribute__((address_space(3))) bf16x8*)(kpb[(j) >> 1] + kn_ + ((j) & 1) * 4096); } while (0)
#define KRDC(j) do { kf[j] = *(const __attribute__((address_space(3))) bf16x8*)(kpb[(j) >> 1] + kc_ + ((j) & 1) * 4096); } while (0)
#define WB(n) do { if ((n) == 0) ATT_WAIT_BAR(0); else if ((n) == 1) ATT_WAIT_BAR(1); else if ((n) == 2) ATT_WAIT_BAR(2); else if ((n) == 3) ATT_WAIT_BAR(3); else if ((n) == 4) ATT_WAIT_BAR(4); else if ((n) == 5) ATT_WAIT_BAR(5); else ATT_WAIT_BAR(10); } while (0)
#define STEP64(t, GK, GV, GL, kq, k1, k3, vq, v3) do { SBAR(); \
    constexpr int vo_ = (vq) * VS, kc_ = (kq) * KS, kn_ = (k1) * KS; (void)kc_; (void)kn_; \
    VRD(0); SBAR(); p0 = MF(kf[0], qr[0], negm); SBAR(); \
    VRD(1); SBAR(); p1 = MF(kf[1], qr[0], negm); SBAR(); \
    VRD(2); SBAR(); p0 = MF(kf[2], qr[1], p0); SBAR(); \
    VRD(3); SBAR(); p1 = MF(kf[3], qr[1], p1); SBAR(); \
    VRD(4); SBAR(); p0 = MF(kf[4], qr[2], p0); SBAR(); \
    VRD(5); SBAR(); p1 = MF(kf[5], qr[2], p1); SBAR(); \
    VRD(6); SBAR(); p0 = MF(kf[6], qr[3], p0); SBAR(); \
    VRD(7); SBAR(); p1 = MF(kf[7], qr[3], p1); SBAR(); \
    if (GK) { DMA_K((t) + 3, k3); } if (GV) { DMA_V((t) + VAH, v3); } \
    if (GL) { KRD(0); } SBAR(); ls = MF16(__builtin_bit_cast(bf16x8, pw[0]), onesb, ls); o[0] = MF(__builtin_bit_cast(bf16x8, pw[0]), VFR(0), o[0]); p0[0] = EX(p0[0]); p0[1] = EX(p0[1]); p0[2] = EX(p0[2]); p0[3] = EX(p0[3]); PIN(p0); SBAR(); \
    if (GL) { KRD(1); } SBAR(); o[1] = MF(__builtin_bit_cast(bf16x8, pw[0]), VFR(1), o[1]); p0[4] = EX(p0[4]); p0[5] = EX(p0[5]); p0[6] = EX(p0[6]); p0[7] = EX(p0[7]); PIN(p0); SBAR(); \
    if (GL) { KRD(2); } SBAR(); ls = MF16(__builtin_bit_cast(bf16x8, pw[1]), onesb, ls); o[0] = MF(__builtin_bit_cast(bf16x8, pw[1]), VFR(2), o[0]); p0[8] = EX(p0[8]); p0[9] = EX(p0[9]); p0[10] = EX(p0[10]); p0[11] = EX(p0[11]); pw[0][0] = cvtpk_s(p0[0], p0[1]); pw[0][1] = cvtpk_s(p0[2], p0[3]); PIN(p0); PIN(pw[0]); SBAR(); \
    if (GL) { KRD(3); } SBAR(); o[1] = MF(__builtin_bit_cast(bf16x8, pw[1]), VFR(3), o[1]); p0[12] = EX(p0[12]); p0[13] = EX(p0[13]); p0[14] = EX(p0[14]); p0[15] = EX(p0[15]); pw[0][2] = cvtpk_s(p0[4], p0[5]); pw[0][3] = cvtpk_s(p0[6], p0[7]); PIN(p0); PIN(pw[0]); SBAR(); \
    if (GL) { KRD(4); } SBAR(); ls = MF16(__builtin_bit_cast(bf16x8, pw[2]), onesb, ls); o[0] = MF(__builtin_bit_cast(bf16x8, pw[2]), VFR(4), o[0]); p1[0] = EX(p1[0]); p1[1] = EX(p1[1]); p1[2] = EX(p1[2]); p1[3] = EX(p1[3]); pw[1][0] = cvtpk_s(p0[8], p0[9]); pw[1][1] = cvtpk_s(p0[10], p0[11]); PIN(p1); PIN(pw[1]); SBAR(); \
    if (GL) { KRD(5); } SBAR(); o[1] = MF(__builtin_bit_cast(bf16x8, pw[2]), VFR(5), o[1]); p1[4] = EX(p1[4]); p1[5] = EX(p1[5]); p1[6] = EX(p1[6]); p1[7] = EX(p1[7]); pw[1][2] = cvtpk_s(p0[12], p0[13]); pw[1][3] = cvtpk_s(p0[14], p0[15]); PIN(p1); PIN(pw[1]); SBAR(); \
    if (GL) { KRD(6); } SBAR(); ls = MF16(__builtin_bit_cast(bf16x8, pw[3]), onesb, ls); o[0] = MF(__builtin_bit_cast(bf16x8, pw[3]), VFR(6), o[0]); p1[8] = EX(p1[8]); p1[9] = EX(p1[9]); p1[10] = EX(p1[10]); p1[11] = EX(p1[11]); pw[2][0] = cvtpk_s(p1[0], p1[1]); pw[2][1] = cvtpk_s(p1[2], p1[3]); PIN(p1); PIN(pw[2]); SBAR(); \
    if (GL) { KRD(7); } SBAR(); o[1] = MF(__builtin_bit_cast(bf16x8, pw[3]), VFR(7), o[1]); p1[12] = EX(p1[12]); p1[13] = EX(p1[13]); p1[14] = EX(p1[14]); p1[15] = EX(p1[15]); pw[2][2] = cvtpk_s(p1[4], p1[5]); pw[2][3] = cvtpk_s(p1[6], p1[7]); PIN(p1); PIN(pw[2]); SBAR(); \
    pw[3][0] = cvtpk_s(p1[8], p1[9]); pw[3][1] = cvtpk_s(p1[10], p1[11]); pw[3][2] = cvtpk_s(p1[12], p1[13]); pw[3][3] = cvtpk_s(p1[14], p1[15]); SBAR(); \
  } while (0)
#define STEP128(t, GK, GV, GL, kq, k1, k3, vq, v3) do { SBAR(); \
    constexpr int vo_ = (vq) * VS, kc_ = (kq) * KS, kn_ = (k1) * KS; (void)kc_; (void)kn_; \
    SBAR(); p0 = MF(kf[0], qr[0], negm); SBAR(); \
    SBAR(); p1 = MF(kf[1], qr[0], negm); SBAR(); \
    SBAR(); p0 = MF(kf[2], qr[1], p0); SBAR(); \
    SBAR(); p1 = MF(kf[3], qr[1], p1); SBAR(); \
    VRD(0); SBAR(); p0 = MF(kf[4], qr[2], p0); SBAR(); \
    VRD(1); SBAR(); p1 = MF(kf[5], qr[2], p1); SBAR(); \
    VRD(2); SBAR(); p0 = MF(kf[6], qr[3], p0); SBAR(); \
    VRD(3); SBAR(); p1 = MF(kf[7], qr[3], p1); SBAR(); \
    if (GK) { DMA_K((t) + 3, k3); } if (GV) { DMA_V((t) + VAH, v3); } \
    VRD(4); SBAR(); ls = MF16(__builtin_bit_cast(bf16x8, pw[0]), onesb, ls); o[0] = MF(__builtin_bit_cast(bf16x8, pw[0]), VFR(0), o[0]); p0[0] = EX(p0[0]); p0[1] = EX(p0[1]); PIN(p0); SBAR(); \
    VRD(5); SBAR(); o[1] = MF(__builtin_bit_cast(bf16x8, pw[0]), VFR(1), o[1]); p0[2] = EX(p0[2]); p0[3] = EX(p0[3]); PIN(p0); SBAR(); \
    VRD(6); SBAR(); o[2] = MF(__builtin_bit_cast(bf16x8, pw[0]), VFR(2), o[2]); p0[4] = EX(p0[4]); p0[5] = EX(p0[5]); PIN(p0); SBAR(); \
    VRD(7); SBAR(); o[3] = MF(__builtin_bit_cast(bf16x8, pw[0]), VFR(3), o[3]); p0[6] = EX(p0[6]); p0[7] = EX(p0[7]); PIN(p0); SBAR(); \
    VRD(8); SBAR(); ls = MF16(__builtin_bit_cast(bf16x8, pw[1]), onesb, ls); o[0] = MF(__builtin_bit_cast(bf16x8, pw[1]), VFR(4), o[0]); p0[8] = EX(p0[8]); p0[9] = EX(p0[9]); pw[0][0] = cvtpk_s(p0[0], p0[1]); PIN(p0); PIN(pw[0]); SBAR(); \
    VRD(9); SBAR(); o[1] = MF(__builtin_bit_cast(bf16x8, pw[1]), VFR(5), o[1]); p0[10] = EX(p0[10]); p0[11] = EX(p0[11]); pw[0][1] = cvtpk_s(p0[2], p0[3]); PIN(p0); PIN(pw[0]); SBAR(); \
    VRD(10); SBAR(); o[2] = MF(__builtin_bit_cast(bf16x8, pw[1]), VFR(6), o[2]); p0[12] = EX(p0[12]); p0[13] = EX(p0[13]); pw[0][2] = cvtpk_s(p0[4], p0[5]); PIN(p0); PIN(pw[0]); SBAR(); \
    VRD(11); SBAR(); o[3] = MF(__builtin_bit_cast(bf16x8, pw[1]), VFR(7), o[3]); p0[14] = EX(p0[14]); p0[15] = EX(p0[15]); pw[0][3] = cvtpk_s(p0[6], p0[7]); PIN(p0); PIN(pw[0]); SBAR(); \
    VRD(12); if (GL) { KRD(0); } SBAR(); ls = MF16(__builtin_bit_cast(bf16x8, pw[2]), onesb, ls); o[0] = MF(__builtin_bit_cast(bf16x8, pw[2]), VFR(8), o[0]); p1[0] = EX(p1[0]); p1[1] = EX(p1[1]); pw[1][0] = cvtpk_s(p0[8], p0[9]); PIN(p1); PIN(pw[1]); SBAR(); \
    VRD(13); if (GL) { KRD(1); } SBAR(); o[1] = MF(__builtin_bit_cast(bf16x8, pw[2]), VFR(9), o[1]); p1[2] = EX(p1[2]); p1[3] = EX(p1[3]); pw[1][1] = cvtpk_s(p0[10], p0[11]); PIN(p1); PIN(pw[1]); SBAR(); \
    VRD(14); if (GL) { KRD(2); } SBAR(); o[2] = MF(__builtin_bit_cast(bf16x8, pw[2]), VFR(10), o[2]); p1[4] = EX(p1[4]); p1[5] = EX(p1[5]); pw[1][2] = cvtpk_s(p0[12], p0[13]); PIN(p1); PIN(pw[1]); SBAR(); \
    VRD(15); if (GL) { KRD(3); } SBAR(); o[3] = MF(__builtin_bit_cast(bf16x8, pw[2]), VFR(11), o[3]); p1[6] = EX(p1[6]); p1[7] = EX(p1[7]); pw[1][3] = cvtpk_s(p0[14], p0[15]); PIN(p1); PIN(pw[1]); SBAR(); \
    if (GL) { KRD(4); } SBAR(); ls = MF16(__builtin_bit_cast(bf16x8, pw[3]), onesb, ls); o[0] = MF(__builtin_bit_cast(bf16x8, pw[3]), VFR(12), o[0]); p1[8] = EX(p1[8]); p1[9] = EX(p1[9]); pw[2][0] = cvtpk_s(p1[0], p1[1]); PIN(p1); PIN(pw[2]); SBAR(); \
    if (GL) { KRD(5); } SBAR(); o[1] = MF(__builtin_bit_cast(bf16x8, pw[3]), VFR(13), o[1]); p1[10] = EX(p1[10]); p1[11] = EX(p1[11]); pw[2][1] = cvtpk_s(p1[2], p1[3]); PIN(p1); PIN(pw[2]); SBAR(); \
    if (GL) { KRD(6); } SBAR(); o[2] = MF(__builtin_bit_cast(bf16x8, pw[3]), VFR(14), o[2]); p1[12] = EX(p1[12]); p1[13] = EX(p1[13]); pw[2][2] = cvtpk_s(p1[4], p1[5]); PIN(p1); PIN(pw[2]); SBAR(); \
    if (GL) { KRD(7); } SBAR(); o[3] = MF(__builtin_bit_cast(bf16x8, pw[3]), VFR(15), o[3]); p1[14] = EX(p1[14]); p1[15] = EX(p1[15]); pw[2][3] = cvtpk_s(p1[6], p1[7]); PIN(p1); PIN(pw[2]); SBAR(); \
    pw[3][0] = cvtpk_s(p1[8], p1[9]); pw[3][1] = cvtpk_s(p1[10], p1[11]); pw[3][2] = cvtpk_s(p1[12], p1[13]); pw[3][3] = cvtpk_s(p1[14], p1[15]); SBAR(); \
  } while (0)
#define STEP64D(N0, N1, O0, O1, t, GK, GV, GL, kq, k1, k3, vq, v3) do { SBAR(); \
    constexpr int vo_ = (vq) * VS, kn_ = (k1) * KS; (void)kn_; \
    VRD(0); SBAR(); N0 = MF(kf[0], qr[0], negm); O1[0] = EX(O1[0]); O1[1] = EX(O1[1]); pw[1][2] = cvtpk_s(O0[12], O0[13]); PIN(pw[1]); PIN(O1); SBAR(); \
    VRD(1); SBAR(); N1 = MF(kf[1], qr[0], negm); O1[2] = EX(O1[2]); O1[3] = EX(O1[3]); pw[1][3] = cvtpk_s(O0[14], O0[15]); PIN(pw[1]); PIN(O1); SBAR(); \
    VRD(2); SBAR(); N0 = MF(kf[2], qr[1], N0); O1[4] = EX(O1[4]); O1[5] = EX(O1[5]); pw[2][0] = cvtpk_s(O1[0], O1[1]); PIN(pw[2]); PIN(O1); SBAR(); \
    VRD(3); SBAR(); N1 = MF(kf[3], qr[1], N1); O1[6] = EX(O1[6]); O1[7] = EX(O1[7]); pw[2][1] = cvtpk_s(O1[2], O1[3]); PIN(pw[2]); PIN(O1); SBAR(); \
    VRD(4); SBAR(); N0 = MF(kf[4], qr[2], N0); O1[8] = EX(O1[8]); O1[9] = EX(O1[9]); pw[2][2] = cvtpk_s(O1[4], O1[5]); PIN(pw[2]); PIN(O1); SBAR(); \
    VRD(5); SBAR(); N1 = MF(kf[5], qr[2], N1); O1[10] = EX(O1[10]); O1[11] = EX(O1[11]); pw[2][3] = cvtpk_s(O1[6], O1[7]); PIN(pw[2]); PIN(O1); SBAR(); \
    VRD(6); SBAR(); N0 = MF(kf[6], qr[3], N0); O1[12] = EX(O1[12]); O1[13] = EX(O1[13]); pw[3][0] = cvtpk_s(O1[8], O1[9]); PIN(pw[3]); PIN(O1); SBAR(); \
    VRD(7); SBAR(); N1 = MF(kf[7], qr[3], N1); O1[14] = EX(O1[14]); O1[15] = EX(O1[15]); pw[3][1] = cvtpk_s(O1[10], O1[11]); PIN(pw[3]); PIN(O1); SBAR(); \
    pw[3][2] = cvtpk_s(O1[12], O1[13]); pw[3][3] = cvtpk_s(O1[14], O1[15]); PIN(pw[3]); SBAR(); \
    if (GK) { DMA_K((t) + 3, k3); } if (GV) { DMA_V((t) + VAH, v3); } \
    if (GL) { KRD(0); } SBAR(); ls = MF16(__builtin_bit_cast(bf16x8, pw[0]), onesb, ls); o[0] = MF(__builtin_bit_cast(bf16x8, pw[0]), VFR(0), o[0]); N0[0] = EX(N0[0]); N0[1] = EX(N0[1]); PIN(N0); SBAR(); \
    if (GL) { KRD(1); } SBAR(); o[1] = MF(__builtin_bit_cast(bf16x8, pw[0]), VFR(1), o[1]); N0[2] = EX(N0[2]); N0[3] = EX(N0[3]); PIN(N0); SBAR(); \
    if (GL) { KRD(2); } SBAR(); ls = MF16(__builtin_bit_cast(bf16x8, pw[1]), onesb, ls); o[0] = MF(__builtin_bit_cast(bf16x8, pw[1]), VFR(2), o[0]); N0[4] = EX(N0[4]); N0[5] = EX(N0[5]); pw[0][0] = cvtpk_s(N0[0], N0[1]); PIN(pw[0]); PIN(N0); SBAR(); \
    if (GL) { KRD(3); } SBAR(); o[1] = MF(__builtin_bit_cast(bf16x8, pw[1]), VFR(3), o[1]); N0[6] = EX(N0[6]); N0[7] = EX(N0[7]); pw[0][1] = cvtpk_s(N0[2], N0[3]); PIN(pw[0]); PIN(N0); SBAR(); \
    if (GL) { KRD(4); } SBAR(); ls = MF16(__builtin_bit_cast(bf16x8, pw[2]), onesb, ls); o[0] = MF(__builtin_bit_cast(bf16x8, pw[2]), VFR(4), o[0]); N0[8] = EX(N0[8]); N0[9] = EX(N0[9]); pw[0][2] = cvtpk_s(N0[4], N0[5]); PIN(pw[0]); PIN(N0); SBAR(); \
    if (GL) { KRD(5); } SBAR(); o[1] = MF(__builtin_bit_cast(bf16x8, pw[2]), VFR(5), o[1]); N0[10] = EX(N0[10]); N0[11] = EX(N0[11]); pw[0][3] = cvtpk_s(N0[6], N0[7]); PIN(pw[0]); PIN(N0); SBAR(); \
    if (GL) { KRD(6); } SBAR(); ls = MF16(__builtin_bit_cast(bf16x8, pw[3]), onesb, ls); o[0] = MF(__builtin_bit_cast(bf16x8, pw[3]), VFR(6), o[0]); N0[12] = EX(N0[12]); N0[13] = EX(N0[13]); pw[1][0] = cvtpk_s(N0[8], N0[9]); PIN(pw[1]); PIN(N0); SBAR(); \
    if (GL) { KRD(7); } SBAR(); o[1] = MF(__builtin_bit_cast(bf16x8, pw[3]), VFR(7), o[1]); N0[14] = EX(N0[14]); N0[15] = EX(N0[15]); pw[1][1] = cvtpk_s(N0[10], N0[11]); PIN(pw[1]); PIN(N0); SBAR(); \
  } while (0)

    f32x16 pb0, pb1;
    DMA_K(0, 0); DMA_V(0, 0); DMA_K(1, 1); DMA_K(2, 2); DMA_V(1, 1);
    WB(2 * NPV + 2 * NPK);
    { const int kn_ = 0;
#pragma unroll
      for (int j = 0; j < 8; ++j) KRD(j); }
#pragma unroll
    for (int d0 = 0; d0 < 4; ++d0) {
        if (d0 == 0) { p0 = MF(kf[0], qr[0], negm); p1 = MF(kf[1], qr[0], negm); } else { p0 = MF(kf[2 * d0], qr[d0], p0); p1 = MF(kf[2 * d0 + 1], qr[d0], p1); } }
    if (DV == 64) {
#pragma unroll
      for (int r = 0; r < 16; ++r) p0[r] = EX(p0[r]);
#pragma unroll
      for (int w = 0; w < 6; ++w) pw[w >> 2][w & 3] = cvtpk_s(p0[2 * w], p0[2 * w + 1]);
    } else {
#pragma unroll
      for (int r = 0; r < 16; ++r) { p0[r] = EX(p0[r]); p1[r] = EX(p1[r]); }
#pragma unroll
      for (int w = 0; w < 8; ++w) { pw[w >> 2][w & 3] = cvtpk_s(p0[2 * w], p0[2 * w + 1]); pw[2 + (w >> 2)][w & 3] = cvtpk_s(p1[2 * w], p1[2 * w + 1]); } }
    WB(0);
    DMA_K(3, 3); DMA_V(VAH, 2);
    { const int kn_ = KS;
#pragma unroll
      for (int j = 0; j < 8; ++j) KRD(j); }
    WB(NPK + NPV);
    static_assert(DV == 64, "the generic body is instantiated for the GQA heads only (diff heads: attn_unit_d16)");
    for (int t = 1; t <= NT - 4; t += 4) {
        STEP64D(pb0, pb1, p0, p1, t, true, true, true, 1, 2, 0, 0, 3);     WB(NPK + NPV);
        STEP64D(p0, p1, pb0, pb1, t + 1, true, true, true, 2, 3, 1, 1, 0); WB(NPK + NPV);
        STEP64D(pb0, pb1, p0, p1, t + 2, true, true, true, 3, 0, 2, 2, 1); WB(NPK + NPV);
        STEP64D(p0, p1, pb0, pb1, t + 3, true, true, true, 0, 1, 3, 3, 2); WB(NPK + NPV);
    }
    STEP64D(pb0, pb1, p0, p1, NT - 3, false, true, true, 1, 2, 0, 0, 3);   WB(NPV);
    STEP64D(p0, p1, pb0, pb1, NT - 2, false, false, true, 2, 3, 1, 1, 0);  WB(0);
    STEP64D(pb0, pb1, p0, p1, NT - 1, false, false, false, 3, 0, 2, 2, 1); WB(0);
    if (DV == 64) {
#pragma unroll
      for (int r = 0; r < 16; ++r) pb1[r] = EX(pb1[r]);
      pw[1][2] = cvtpk_s(pb0[12], pb0[13]); pw[1][3] = cvtpk_s(pb0[14], pb0[15]);
#pragma unroll
      for (int w = 0; w < 8; ++w) pw[2 + (w >> 2)][w & 3] = cvtpk_s(pb1[2 * w], pb1[2 * w + 1]);
    }
    { constexpr int vo_ = 3 * VS;
#pragma unroll
      for (int i = 0; i < 4 * ND; ++i) { VRD(i); o[i % ND] = MF(__builtin_bit_cast(bf16x8, pw[i / ND]), VFR(i), o[i % ND]); }
#pragma unroll
      for (int ks = 0; ks < 4; ++ks) ls = MF16(__builtin_bit_cast(bf16x8, pw[ks]), onesb, ls); }
    int lane_e = lane; asm volatile("" : "+v"(lane_e));
    const int r32_e = lane_e & 31, hi_e = lane_e >> 5;
    float* wsf = (float*)(shm + LDS_WSF) + wid * 64;
    { const int c16 = lane_e & 15, rb = 4 * (lane_e >> 4);
      if ((c16 & 7) == 0) {
#pragma unroll
          for (int g = 0; g < 4; ++g) wsf[2 * c16 + rb + g] = ls[g]; } }
    asm volatile("s_waitcnt lgkmcnt(0)\n\ts_barrier" ::: "memory");
    float rli[16];
#pragma unroll
    for (int r = 0; r < 16; ++r) rli[r] = __builtin_amdgcn_rcpf(wsf[crow(r, hi_e)]);
    if (DV == 64) {
        bf16_t* stg = (bf16_t*)shm + wid * 2048;
#pragma unroll
        for (int r = 0; r < 16; ++r) { const int orow = crow(r, hi_e);
#pragma unroll
            for (int d0 = 0; d0 < ND; ++d0) stg[orow * 64 + d0 * 32 + r32_e] = (bf16_t)(cvtpk_s(o[d0][r] * rli[r], 0.f) & 0xffffu); }
        asm volatile("s_waitcnt lgkmcnt(0)" ::: "memory");
#pragma unroll
        for (int i = 0; i < 4; ++i) { const int row = i * 8 + (lane_e >> 3), ch = lane_e & 7; const u32x4 v = *(const u32x4*)(stg + row * 64 + ch * 8); *(u32x4*)(U.Ow + (size_t)row * D + ch * 8) = v; }
    } else {
        float* X = (float*)shm + (wid & 3) * 4096;
        if (wid >= 4) {
#pragma unroll
            for (int r = 0; r < 16; ++r) { const int orow = crow(r, hi_e);
#pragma unroll
                for (int d0 = 0; d0 < ND; ++d0) X[orow * 128 + d0 * 32 + r32_e] = o[d0][r] * rli[r] * lam; }
        }
        asm volatile("s_waitcnt lgkmcnt(0)\n\ts_barrier" ::: "memory");
        if (wid < 4) {
#pragma unroll
            for (int r = 0; r < 16; ++r) { const int orow = crow(r, hi_e);
#pragma unroll
                for (int d0 = 0; d0 < ND; ++d0) { const int a = orow * 128 + d0 * 32 + r32_e; X[a] = o[d0][r] * rli[r] - X[a]; } }
            asm volatile("s_waitcnt lgkmcnt(0)" ::: "memory");
            const int ch = lane_e & 15;
            const f32x4 w0 = *(const f32x4*)(subw + ch * 8), w1 = *(const f32x4*)(subw + ch * 8 + 4);
#pragma unroll
            for (int i = 0; i < 8; ++i) { const int row = i * 4 + (lane_e >> 4);
                const f32x4 v0 = *(const f32x4*)(X + row * 128 + ch * 8), v1 = *(const f32x4*)(X + row * 128 + ch * 8 + 4);
                float ss = v0[0] * v0[0] + v0[1] * v0[1] + v0[2] * v0[2] + v0[3] * v0[3] + v1[0] * v1[0] + v1[1] * v1[1] + v1[2] * v1[2] + v1[3] * v1[3];
                ss += __shfl_xor(ss, 1); ss += __shfl_xor(ss, 2); ss += __shfl_xor(ss, 4); ss += __shfl_xor(ss, 8);
                const float rs = (1.0f - LAMBDA_INIT) / sqrtf(ss * (1.0f / 128.0f) + EPS);
                u32x4 w; w.x = cvtpk_s(v0[0] * rs * w0[0], v0[1] * rs * w0[1]); w.y = cvtpk_s(v0[2] * rs * w0[2], v0[3] * rs * w0[3]);
                w.z = cvtpk_s(v1[0] * rs * w1[0], v1[1] * rs * w1[1]); w.w = cvtpk_s(v1[2] * rs * w1[2], v1[3] * rs * w1[3]);
                *(u32x4*)(U.Ow + (size_t)row * D + ch * 8) = w; }
        }
    }
    asm volatile("s_waitcnt lgkmcnt(0)\n\ts_barrier" ::: "memory");
#undef DMA_K
#undef DMA_V
#undef SBAR
#undef PIN
#undef MF
#undef EX
#undef MF16
#undef VRD
#undef VFR
#undef KRD
#undef KRDC
#undef WB
#undef STEP64
#undef STEP128
#undef STEP64D
}

__device__ __forceinline__ void attn_unit_d16(const UnitDesc& U, char* shm, float lam, const float* subw) {
    constexpr int KS = 16384, VS = 16384, NPK = 2, NPV = 2, NKS = 4, VAH = 2, LDS_K = 0, LDS_V = NKS * KS;
    typedef float f32x4v __attribute__((ext_vector_type(4)));
    const int tid = threadIdx.x, lane = tid & 63, c16 = lane & 15, g = lane >> 4; const int wid = __builtin_amdgcn_readfirstlane(tid >> 6);
    const unsigned lds0 = (unsigned)(uintptr_t)shm;
    const int map = wid >> 2;
    unsigned koff, voff; unsigned kdst[NPK], vdst[NPV];
    { const int key = 8 * wid + (lane >> 3), pp = lane & 7;
      koff = (unsigned)(key * U.KP + (pp ^ ((key >> 1) & 7)) * 8) * 2u; voff = (unsigned)(key * U.VP + ((((pp >> 1) ^ ((key >> 1) & 3)) << 1) + (pp & 1)) * 8) * 2u;
#pragma unroll
      for (int pc = 0; pc < NPK; ++pc) kdst[pc] = lds0 + LDS_K + pc * 8192 + wid * 1024;
#pragma unroll
      for (int pc = 0; pc < NPV; ++pc) vdst[pc] = lds0 + LDS_V + pc * 8192 + wid * 1024; }
#define DMA_K(t, slot) do { _Pragma("unroll") for (int pc_ = 0; pc_ < NPK; ++pc_) glds16s(U.Kt + (size_t)(t) * 64 * U.KP + pc_ * 64, koff, (unsigned)__builtin_amdgcn_readfirstlane(kdst[pc_] + (slot) * KS)); } while (0)
#define DMA_V(t, slot) do { _Pragma("unroll") for (int pc_ = 0; pc_ < NPV; ++pc_) glds16s(U.Vt + (size_t)(t) * 64 * U.VP + pc_ * 64, voff, (unsigned)__builtin_amdgcn_readfirstlane(vdst[pc_] + (slot) * VS)); } while (0)
    const lds_cptr shm3 = (lds_cptr)shm;
    lds_cptr kpb[2];
#pragma unroll
    for (int ds = 0; ds < 2; ++ds) kpb[ds] = shm3 + LDS_K + map * 8192 + c16 * 128 + (((4 * ds + g) ^ (c16 >> 1)) << 4);
    lds_cptr vpb[4];
    { const int q4 = c16 >> 2, p = c16 & 3, ko = 4 * g + q4, swz = (ko >> 1) & 3;
#pragma unroll
      for (int b = 0; b < 4; ++b) vpb[b] = shm3 + LDS_V + ko * 128 + ((b ^ swz) << 5) + p * 8; }
    bf16x8 qr[2][2];
#pragma unroll
    for (int qt = 0; qt < 2; ++qt)
#pragma unroll
        for (int ds = 0; ds < 2; ++ds) qr[qt][ds] = *reinterpret_cast<const bf16x8*>(U.Qw + (size_t)(16 * qt + c16) * 512 + 32 * ds + 8 * g);
    const f32x4v zero4 = {0.f, 0.f, 0.f, 0.f};
    f32x4v o[2][8], S[4][2], ls[2];
#pragma unroll
    for (int qt = 0; qt < 2; ++qt) { ls[qt] = zero4;
#pragma unroll
        for (int dt = 0; dt < 8; ++dt) o[qt][dt] = zero4; }
    const bf16x8 onesb = {(short)0x3F80, (short)0x3F80, (short)0x3F80, (short)0x3F80, (short)0x3F80, (short)0x3F80, (short)0x3F80, (short)0x3F80};
    u32x4 pa[2][2]; bf16x8 kf[4][2]; s16x4 vlo[16], vhi[16];
#define SBAR() __builtin_amdgcn_sched_barrier(0)
#define PIN(x) asm volatile("" : "+v"(x))
#define MF16(a, b, c) __builtin_amdgcn_mfma_f32_16x16x32_bf16(a, b, c, 0, 0, 0)
#define EX(v) __builtin_amdgcn_exp2f(v)
#define VRD16(f) do { vlo[f] = vtr(vpb[(f) & 3] + vo_ + (((f) >> 2) & 1) * 8192 + ((f) >> 3) * 4096); vhi[f] = vtr(vpb[(f) & 3] + vo_ + (((f) >> 2) & 1) * 8192 + ((f) >> 3) * 4096 + 2048); } while (0)
#define VFR16(f) (bf16x8){vlo[f][0], vlo[f][1], vlo[f][2], vlo[f][3], vhi[f][0], vhi[f][1], vhi[f][2], vhi[f][3]}
#define KRD16(j) do { kf[(j) >> 1][(j) & 1] = *(const __attribute__((address_space(3))) bf16x8*)(kpb[(j) & 1] + kn_ + ((j) >> 1) * 2048); } while (0)
#define STEP_D16(t, GK, GV, GL, kq, k1, k3, vq, v3) do { SBAR(); \
    constexpr int vo_ = (vq) * VS, kn_ = (k1) * KS; (void)kn_; \
    VRD16(0); SBAR(); S[0][0] = MF16(kf[0][0], qr[0][0], zero4); SBAR(); \
    SBAR(); S[0][0] = MF16(kf[0][1], qr[0][1], S[0][0]); SBAR(); \
    VRD16(1); SBAR(); S[0][1] = MF16(kf[0][0], qr[1][0], zero4); SBAR(); \
    SBAR(); S[0][1] = MF16(kf[0][1], qr[1][1], S[0][1]); SBAR(); \
    VRD16(2); SBAR(); S[1][0] = MF16(kf[1][0], qr[0][0], zero4); SBAR(); \
    SBAR(); S[1][0] = MF16(kf[1][1], qr[0][1], S[1][0]); SBAR(); \
    VRD16(3); SBAR(); S[1][1] = MF16(kf[1][0], qr[1][0], zero4); SBAR(); \
    SBAR(); S[1][1] = MF16(kf[1][1], qr[1][1], S[1][1]); SBAR(); \
    VRD16(4); SBAR(); S[2][0] = MF16(kf[2][0], qr[0][0], zero4); SBAR(); \
    SBAR(); S[2][0] = MF16(kf[2][1], qr[0][1], S[2][0]); SBAR(); \
    VRD16(5); SBAR(); S[2][1] = MF16(kf[2][0], qr[1][0], zero4); SBAR(); \
    SBAR(); S[2][1] = MF16(kf[2][1], qr[1][1], S[2][1]); SBAR(); \
    VRD16(6); SBAR(); S[3][0] = MF16(kf[3][0], qr[0][0], zero4); SBAR(); \
    SBAR(); S[3][0] = MF16(kf[3][1], qr[0][1], S[3][0]); SBAR(); \
    VRD16(7); SBAR(); S[3][1] = MF16(kf[3][0], qr[1][0], zero4); SBAR(); \
    SBAR(); S[3][1] = MF16(kf[3][1], qr[1][1], S[3][1]); SBAR(); \
    if (GK) { DMA_K((t) + 3, k3); } if (GV) { DMA_V((t) + VAH, v3); } \
    VRD16(8); SBAR(); ls[0] = MF16(__builtin_bit_cast(bf16x8, pa[0][0]), onesb, ls[0]); o[0][0] = MF16(__builtin_bit_cast(bf16x8, pa[0][0]), VFR16(0), o[0][0]); S[0][0][0] = EX(S[0][0][0]); PIN(S[0][0]); SBAR(); \
    SBAR(); ls[1] = MF16(__builtin_bit_cast(bf16x8, pa[1][0]), onesb, ls[1]); o[1][0] = MF16(__builtin_bit_cast(bf16x8, pa[1][0]), VFR16(0), o[1][0]); S[0][0][1] = EX(S[0][0][1]); PIN(S[0][0]); SBAR(); \
    VRD16(9); SBAR(); o[0][1] = MF16(__builtin_bit_cast(bf16x8, pa[0][0]), VFR16(1), o[0][1]); S[0][0][2] = EX(S[0][0][2]); PIN(S[0][0]); SBAR(); \
    SBAR(); o[1][1] = MF16(__builtin_bit_cast(bf16x8, pa[1][0]), VFR16(1), o[1][1]); S[0][0][3] = EX(S[0][0][3]); PIN(S[0][0]); SBAR(); \
    VRD16(10); SBAR(); o[0][2] = MF16(__builtin_bit_cast(bf16x8, pa[0][0]), VFR16(2), o[0][2]); S[0][1][0] = EX(S[0][1][0]); PIN(S[0][1]); SBAR(); \
    SBAR(); o[1][2] = MF16(__builtin_bit_cast(bf16x8, pa[1][0]), VFR16(2), o[1][2]); S[0][1][1] = EX(S[0][1][1]); PIN(S[0][1]); SBAR(); \
    VRD16(11); SBAR(); o[0][3] = MF16(__builtin_bit_cast(bf16x8, pa[0][0]), VFR16(3), o[0][3]); S[0][1][2] = EX(S[0][1][2]); PIN(S[0][1]); SBAR(); \
    SBAR(); o[1][3] = MF16(__builtin_bit_cast(bf16x8, pa[1][0]), VFR16(3), o[1][3]); S[0][1][3] = EX(S[0][1][3]); PIN(S[0][1]); SBAR(); \
    VRD16(12); SBAR(); o[0][4] = MF16(__builtin_bit_cast(bf16x8, pa[0][0]), VFR16(4), o[0][4]); S[1][0][0] = EX(S[1][0][0]); PIN(S[1][0]); SBAR(); \
    SBAR(); o[1][4] = MF16(__builtin_bit_cast(bf16x8, pa[1][0]), VFR16(4), o[1][4]); S[1][0][1] = EX(S[1][0][1]); PIN(S[1][0]); SBAR(); \
    VRD16(13); SBAR(); o[0][5] = MF16(__builtin_bit_cast(bf16x8, pa[0][0]), VFR16(5), o[0][5]); S[1][0][2] = EX(S[1][0][2]); PIN(S[1][0]); SBAR(); \
    SBAR(); o[1][5] = MF16(__builtin_bit_cast(bf16x8, pa[1][0]), VFR16(5), o[1][5]); S[1][0][3] = EX(S[1][0][3]); PIN(S[1][0]); SBAR(); \
    VRD16(14); SBAR(); o[0][6] = MF16(__builtin_bit_cast(bf16x8, pa[0][0]), VFR16(6), o[0][6]); S[1][1][0] = EX(S[1][1][0]); PIN(S[1][1]); SBAR(); \
    SBAR(); o[1][6] = MF16(__builtin_bit_cast(bf16x8, pa[1][0]), VFR16(6), o[1][6]); S[1][1][1] = EX(S[1][1][1]); PIN(S[1][1]); SBAR(); \
    VRD16(15); SBAR(); o[0][7] = MF16(__builtin_bit_cast(bf16x8, pa[0][0]), VFR16(7), o[0][7]); S[1][1][2] = EX(S[1][1][2]); PIN(S[1][1]); SBAR(); \
    SBAR(); o[1][7] = MF16(__builtin_bit_cast(bf16x8, pa[1][0]), VFR16(7), o[1][7]); S[1][1][3] = EX(S[1][1][3]); PIN(S[1][1]); SBAR(); \
    if (GL) { KRD16(0); } SBAR(); ls[0] = MF16(__builtin_bit_cast(bf16x8, pa[0][1]), onesb, ls[0]); o[0][0] = MF16(__builtin_bit_cast(bf16x8, pa[0][1]), VFR16(8), o[0][0]); S[2][0][0] = EX(S[2][0][0]); pa[0][0][0] = cvtpk_s(S[0][0][0], S[0][0][1]); PIN(S[2][0]); PIN(pa[0][0]); SBAR(); \
    SBAR(); ls[1] = MF16(__builtin_bit_cast(bf16x8, pa[1][1]), onesb, ls[1]); o[1][0] = MF16(__builtin_bit_cast(bf16x8, pa[1][1]), VFR16(8), o[1][0]); S[2][0][1] = EX(S[2][0][1]); pa[0][0][1] = cvtpk_s(S[0][0][2], S[0][0][3]); PIN(S[2][0]); PIN(pa[0][0]); SBAR(); \
    if (GL) { KRD16(1); } SBAR(); o[0][1] = MF16(__builtin_bit_cast(bf16x8, pa[0][1]), VFR16(9), o[0][1]); S[2][0][2] = EX(S[2][0][2]); pa[0][0][2] = cvtpk_s(S[1][0][0], S[1][0][1]); PIN(S[2][0]); PIN(pa[0][0]); SBAR(); \
    SBAR(); o[1][1] = MF16(__builtin_bit_cast(bf16x8, pa[1][1]), VFR16(9), o[1][1]); S[2][0][3] = EX(S[2][0][3]); pa[0][0][3] = cvtpk_s(S[1][0][2], S[1][0][3]); PIN(S[2][0]); PIN(pa[0][0]); SBAR(); \
    if (GL) { KRD16(2); } SBAR(); o[0][2] = MF16(__builtin_bit_cast(bf16x8, pa[0][1]), VFR16(10), o[0][2]); S[2][1][0] = EX(S[2][1][0]); pa[1][0][0] = cvtpk_s(S[0][1][0], S[0][1][1]); PIN(S[2][1]); PIN(pa[1][0]); SBAR(); \
    SBAR(); o[1][2] = MF16(__builtin_bit_cast(bf16x8, pa[1][1]), VFR16(10), o[1][2]); S[2][1][1] = EX(S[2][1][1]); pa[1][0][1] = cvtpk_s(S[0][1][2], S[0][1][3]); PIN(S[2][1]); PIN(pa[1][0]); SBAR(); \
    if (GL) { KRD16(3); } SBAR(); o[0][3] = MF16(__builtin_bit_cast(bf16x8, pa[0][1]), VFR16(11), o[0][3]); S[2][1][2] = EX(S[2][1][2]); pa[1][0][2] = cvtpk_s(S[1][1][0], S[1][1][1]); PIN(S[2][1]); PIN(pa[1][0]); SBAR(); \
    SBAR(); o[1][3] = MF16(__builtin_bit_cast(bf16x8, pa[1][1]), VFR16(11), o[1][3]); S[2][1][3] = EX(S[2][1][3]); pa[1][0][3] = cvtpk_s(S[1][1][2], S[1][1][3]); PIN(S[2][1]); PIN(pa[1][0]); SBAR(); \
    if (GL) { KRD16(4); } SBAR(); o[0][4] = MF16(__builtin_bit_cast(bf16x8, pa[0][1]), VFR16(12), o[0][4]); S[3][0][0] = EX(S[3][0][0]); PIN(S[3][0]); SBAR(); \
    SBAR(); o[1][4] = MF16(__builtin_bit_cast(bf16x8, pa[1][1]), VFR16(12), o[1][4]); S[3][0][1] = EX(S[3][0][1]); PIN(S[3][0]); SBAR(); \
    if (GL) { KRD16(5); } SBAR(); o[0][5] = MF16(__builtin_bit_cast(bf16x8, pa[0][1]), VFR16(13), o[0][5]); S[3][0][2] = EX(S[3][0][2]); PIN(S[3][0]); SBAR(); \
    SBAR(); o[1][5] = MF16(__builtin_bit_cast(bf16x8, pa[1][1]), VFR16(13), o[1][5]); S[3][0][3] = EX(S[3][0][3]); PIN(S[3][0]); SBAR(); \
    if (GL) { KRD16(6); } SBAR(); o[0][6] = MF16(__builtin_bit_cast(bf16x8, pa[0][1]), VFR16(14), o[0][6]); S[3][1][0] = EX(S[3][1][0]); PIN(S[3][1]); SBAR(); \
    SBAR(); o[1][6] = MF16(__builtin_bit_cast(bf16x8, pa[1][1]), VFR16(14), o[1][6]); S[3][1][1] = EX(S[3][1][1]); PIN(S[3][1]); SBAR(); \
    if (GL) { KRD16(7); } SBAR(); o[0][7] = MF16(__builtin_bit_cast(bf16x8, pa[0][1]), VFR16(15), o[0][7]); S[3][1][2] = EX(S[3][1][2]); PIN(S[3][1]); SBAR(); \
    SBAR(); o[1][7] = MF16(__builtin_bit_cast(bf16x8, pa[1][1]), VFR16(15), o[1][7]); S[3][1][3] = EX(S[3][1][3]); PIN(S[3][1]); SBAR(); \
    pa[0][1][0] = cvtpk_s(S[2][0][0], S[2][0][1]); pa[0][1][1] = cvtpk_s(S[2][0][2], S[2][0][3]); pa[0][1][2] = cvtpk_s(S[3][0][0], S[3][0][1]); pa[0][1][3] = cvtpk_s(S[3][0][2], S[3][0][3]); pa[1][1][0] = cvtpk_s(S[2][1][0], S[2][1][1]); pa[1][1][1] = cvtpk_s(S[2][1][2], S[2][1][3]); pa[1][1][2] = cvtpk_s(S[3][1][0], S[3][1][1]); pa[1][1][3] = cvtpk_s(S[3][1][2], S[3][1][3]); PIN(pa[0][1]); PIN(pa[1][1]); SBAR(); \
  } while (0)

    DMA_K(0, 0); DMA_V(0, 0); DMA_K(1, 1); DMA_K(2, 2); DMA_V(1, 1);
    ATT_WAIT_BAR(8);
    { const int kn_ = 0;
#pragma unroll
      for (int j = 0; j < 8; ++j) KRD16(j); }
#pragma unroll
    for (int kt = 0; kt < 4; ++kt)
#pragma unroll
        for (int qt = 0; qt < 2; ++qt) { S[kt][qt] = MF16(kf[kt][0], qr[qt][0], zero4); S[kt][qt] = MF16(kf[kt][1], qr[qt][1], S[kt][qt]); }
#pragma unroll
    for (int kt = 0; kt < 4; ++kt)
#pragma unroll
        for (int qt = 0; qt < 2; ++qt)
#pragma unroll
            for (int r = 0; r < 4; ++r) S[kt][qt][r] = EX(S[kt][qt][r]);
#pragma unroll
    for (int qt = 0; qt < 2; ++qt)
#pragma unroll
        for (int ks = 0; ks < 2; ++ks) { pa[qt][ks][0] = cvtpk_s(S[2 * ks][qt][0], S[2 * ks][qt][1]); pa[qt][ks][1] = cvtpk_s(S[2 * ks][qt][2], S[2 * ks][qt][3]);
                                         pa[qt][ks][2] = cvtpk_s(S[2 * ks + 1][qt][0], S[2 * ks + 1][qt][1]); pa[qt][ks][3] = cvtpk_s(S[2 * ks + 1][qt][2], S[2 * ks + 1][qt][3]); }
    ATT_WAIT_BAR(0);
    DMA_K(3, 3); DMA_V(VAH, 2);
    { const int kn_ = KS;
#pragma unroll
      for (int j = 0; j < 8; ++j) KRD16(j); }
    ATT_WAIT_BAR(4);
    for (int t = 1; t <= NT - 4; t += 4) {
        STEP_D16(t, true, true, true, 1, 2, 0, 0, 3);     ATT_WAIT_BARV(4);
        STEP_D16(t + 1, true, true, true, 2, 3, 1, 1, 0); ATT_WAIT_BARV(4);
        STEP_D16(t + 2, true, true, true, 3, 0, 2, 2, 1); ATT_WAIT_BARV(4);
        STEP_D16(t + 3, true, true, true, 0, 1, 3, 3, 2); ATT_WAIT_BARV(4);
    }
    STEP_D16(NT - 3, false, true, true, 1, 2, 0, 0, 3);   ATT_WAIT_BAR(2);
    STEP_D16(NT - 2, false, false, true, 2, 3, 1, 1, 0);  ATT_WAIT_BAR(0);
    STEP_D16(NT - 1, false, false, false, 3, 0, 2, 2, 1); ATT_WAIT_BAR(0);
    { constexpr int vo_ = 3 * VS;
#pragma unroll
      for (int f = 0; f < 16; ++f) { VRD16(f);
#pragma unroll
          for (int qt = 0; qt < 2; ++qt) o[qt][f & 7] = MF16(__builtin_bit_cast(bf16x8, pa[qt][f >> 3]), VFR16(f), o[qt][f & 7]); }
#pragma unroll
      for (int qt = 0; qt < 2; ++qt)
#pragma unroll
          for (int ks = 0; ks < 2; ++ks) ls[qt] = MF16(__builtin_bit_cast(bf16x8, pa[qt][ks]), onesb, ls[qt]); }
    int lane_e = lane; asm volatile("" : "+v"(lane_e));
    const int c16_e = lane_e & 15, g_e = lane_e >> 4;
    asm volatile("s_waitcnt lgkmcnt(0)\n\ts_barrier" ::: "memory");
    float* X = (float*)shm + (wid & 3) * 4096;
    if (wid >= 4) {
#pragma unroll
        for (int qt = 0; qt < 2; ++qt)
#pragma unroll
            for (int r = 0; r < 4; ++r) { const float sc = __builtin_amdgcn_rcpf(ls[qt][r]) * lam; const int row = 16 * qt + 4 * g_e + r;
#pragma unroll
                for (int dt = 0; dt < 8; ++dt) X[row * 128 + 16 * dt + c16_e] = o[qt][dt][r] * sc; }
    }
    asm volatile("s_waitcnt lgkmcnt(0)\n\ts_barrier" ::: "memory");
    if (wid < 4) {
#pragma unroll
        for (int qt = 0; qt < 2; ++qt)
#pragma unroll
            for (int r = 0; r < 4; ++r) { const float sc = __builtin_amdgcn_rcpf(ls[qt][r]); const int row = 16 * qt + 4 * g_e + r;
#pragma unroll
                for (int dt = 0; dt < 8; ++dt) { const int a = row * 128 + 16 * dt + c16_e; X[a] = o[qt][dt][r] * sc - X[a]; } }
        asm volatile("s_waitcnt lgkmcnt(0)" ::: "memory");
        const int ch = lane_e & 15;
        const f32x4 w0 = *(const f32x4*)(subw + ch * 8), w1 = *(const f32x4*)(subw + ch * 8 + 4);
#pragma unroll
        for (int i = 0; i < 8; ++i) { const int row = i * 4 + (lane_e >> 4);
            const f32x4 v0 = *(const f32x4*)(X + row * 128 + ch * 8), v1 = *(const f32x4*)(X + row * 128 + ch * 8 + 4);
            float ss = v0[0] * v0[0] + v0[1] * v0[1] + v0[2] * v0[2] + v0[3] * v0[3] + v1[0] * v1[0] + v1[1] * v1[1] + v1[2] * v1[2] + v1[3] * v1[3];
            ss += __shfl_xor(ss, 1); ss += __shfl_xor(ss, 2); ss += __shfl_xor(ss, 4); ss += __shfl_xor(ss, 8);
            const float rs = (1.0f - LAMBDA_INIT) / sqrtf(ss * (1.0f / 128.0f) + EPS);
            u32x4 w; w.x = cvtpk_s(v0[0] * rs * w0[0], v0[1] * rs * w0[1]); w.y = cvtpk_s(v0[2] * rs * w0[2], v0[3] * rs * w0[3]);
            w.z = cvtpk_s(v1[0] * rs * w1[0], v1[1] * rs * w1[1]); w.w = cvtpk_s(v1[2] * rs * w1[2], v1[3] * rs * w1[3]);
            *(u32x4*)(U.Ow + (size_t)row * D + ch * 8) = w; }
    }
    asm volatile("s_waitcnt lgkmcnt(0)\n\ts_barrier" ::: "memory");
#undef DMA_K
#undef DMA_V
#undef SBAR
#undef PIN
#undef MF16
#undef EX
#undef VRD16
#undef VFR16
#undef KRD16
#undef STEP_D16
}
}
namespace attn {
typedef int i32x8 __attribute__((ext_vector_type(8)));
typedef int i32x4 __attribute__((ext_vector_type(4)));
struct UnitDesc8 {
    const unsigned char* Qw;
    const unsigned char* Kt;
    const unsigned char* Vt;
    bf16_t* Ow; int OP;
};
__device__ __forceinline__ int pk8(int old, float x0, float x1, float x2, float x3) { int w = __builtin_amdgcn_cvt_pk_fp8_f32(x0, x1, old, false); w = __builtin_amdgcn_cvt_pk_fp8_f32(x2, x3, w, true); return w; }

__device__ __forceinline__ void attn_unit_f8(const UnitDesc8& U, char* shm) {
    constexpr int TS = 4096, LDS_K = 0, LDS_V = 4 * TS, VAH = 2;
    const int tid = threadIdx.x, lane = tid & 63, r32 = lane & 31, hi = lane >> 5; const int wid = __builtin_amdgcn_readfirstlane(tid >> 6);
    const unsigned lds0 = (unsigned)(uintptr_t)shm;
    const bool kw = wid < 4; const int piece = wid & 3;
    const unsigned char* dsrc = kw ? U.Kt : U.Vt;
    unsigned dvoff; { const int r = 16 * piece + (lane >> 2), ps = lane & 3; dvoff = (unsigned)(r * 64 + ((ps ^ ((r >> 2) & 3)) << 4)); }
    const unsigned ddst = lds0 + (kw ? LDS_K : LDS_V) + piece * 1024;
    const int dlead = kw ? 3 : VAH;
#define DMA8(t, slot) glds16s(dsrc + (size_t)((t) + dlead) * TS, dvoff, (unsigned)__builtin_amdgcn_readfirstlane(ddst + (slot) * TS))
    const lds_cptr shm3 = (lds_cptr)shm;
    const int sw = (r32 >> 2) & 3;
    const lds_cptr fb0 = shm3 + r32 * 64 + (((2 * hi) ^ sw) << 4), fb1 = shm3 + r32 * 64 + (((2 * hi + 1) ^ sw) << 4);
#define RD16(p, off) (*(const __attribute__((address_space(3))) i32x4*)((p) + (off)))
#define FRAG(dst, off) do { const i32x4 lo_ = RD16(fb0, off), hi_ = RD16(fb1, off); dst = (i32x8){lo_[0], lo_[1], lo_[2], lo_[3], hi_[0], hi_[1], hi_[2], hi_[3]}; } while (0)
    i32x8 qf; { const i32x4 a_ = *(const i32x4*)(U.Qw + r32 * 64 + 32 * hi), b_ = *(const i32x4*)(U.Qw + r32 * 64 + 32 * hi + 16); qf = (i32x8){a_[0], a_[1], a_[2], a_[3], b_[0], b_[1], b_[2], b_[3]}; }
    f32x16 cb = {-4.f, -4.f, -4.f, -4.f, -4.f, -4.f, -4.f, -4.f, -4.f, -4.f, -4.f, -4.f, -4.f, -4.f, -4.f, -4.f};
    i32x8 ones8 = {0x38383838, 0x38383838, 0x38383838, 0x38383838, 0x38383838, 0x38383838, 0x38383838, 0x38383838};
    asm volatile("" : "+v"(cb)); asm volatile("" : "+v"(ones8));
    constexpr int SC1 = 0x7F7F7F7F, SCQ = 0x7C7C7C7C;
#define MFQK(a) __builtin_amdgcn_mfma_scale_f32_32x32x64_f8f6f4(a, qf, cb, 0, 0, 0, SC1, 0, SCQ)
#define MFPV(p, v, c) __builtin_amdgcn_mfma_scale_f32_32x32x64_f8f6f4(p, v, c, 0, 0, 0, SC1, 0, SC1)
    f32x16 o[2] = {f32x16{}, f32x16{}}, ls = f32x16{};
    f32x16 p0, p1, pb0, pb1; i32x8 pfA = {0, 0, 0, 0, 0, 0, 0, 0}, pfB = {0, 0, 0, 0, 0, 0, 0, 0}, kf[2], vf[2];
#define SBAR() __builtin_amdgcn_sched_barrier(0)
#define PIN(x) asm volatile("" : "+v"(x))
#define EX(v) __builtin_amdgcn_exp2f(v)
#define WB(n) do { if ((n) == 0) ATT_WAIT_BAR(0); else if ((n) == 1) ATT_WAIT_BAR(1); else ATT_WAIT_BAR(2); } while (0)
#define STEP_F8(N0, N1, O0, O1, PN, PO, t, GK, GV, GL, k1, k3, vq, v3) do { SBAR(); \
    FRAG(vf[0], LDS_V + (vq) * TS); FRAG(vf[1], LDS_V + (vq) * TS + 2048); SBAR(); \
    N0 = MFQK(kf[0]); \
    O1[4] = EX(O1[4]); O1[5] = EX(O1[5]); O1[6] = EX(O1[6]); O1[7] = EX(O1[7]); O1[8] = EX(O1[8]); O1[9] = EX(O1[9]); PO[3] = pk8(PO[3], O0[12], O0[13], O0[14], O0[15]); PIN(O1); PIN(PO); SBAR(); \
    N1 = MFQK(kf[1]); \
    O1[10] = EX(O1[10]); O1[11] = EX(O1[11]); O1[12] = EX(O1[12]); O1[13] = EX(O1[13]); O1[14] = EX(O1[14]); O1[15] = EX(O1[15]); PO[4] = pk8(PO[4], O1[0], O1[1], O1[2], O1[3]); PO[5] = pk8(PO[5], O1[4], O1[5], O1[6], O1[7]); PIN(O1); PIN(PO); SBAR(); \
    PO[6] = pk8(PO[6], O1[8], O1[9], O1[10], O1[11]); PO[7] = pk8(PO[7], O1[12], O1[13], O1[14], O1[15]); PIN(PO); SBAR(); \
    if (kw ? (GK) : (GV)) DMA8(t, kw ? (k3) : (v3)); \
    if (GL) { FRAG(kf[0], LDS_K + (k1) * TS); FRAG(kf[1], LDS_K + (k1) * TS + 2048); } SBAR(); \
    o[0] = MFPV(PO, vf[0], o[0]); \
    N0[0] = EX(N0[0]); N0[1] = EX(N0[1]); N0[2] = EX(N0[2]); N0[3] = EX(N0[3]); N0[4] = EX(N0[4]); N0[5] = EX(N0[5]); N0[6] = EX(N0[6]); PIN(N0); SBAR(); \
    o[1] = MFPV(PO, vf[1], o[1]); \
    N0[7] = EX(N0[7]); N0[8] = EX(N0[8]); N0[9] = EX(N0[9]); N0[10] = EX(N0[10]); N0[11] = EX(N0[11]); N0[12] = EX(N0[12]); N0[13] = EX(N0[13]); PN[0] = pk8(PN[0], N0[0], N0[1], N0[2], N0[3]); PIN(N0); PIN(PN); SBAR(); \
    ls = MFPV(PO, ones8, ls); \
    N0[14] = EX(N0[14]); N0[15] = EX(N0[15]); N1[0] = EX(N1[0]); N1[1] = EX(N1[1]); N1[2] = EX(N1[2]); N1[3] = EX(N1[3]); PN[1] = pk8(PN[1], N0[4], N0[5], N0[6], N0[7]); PN[2] = pk8(PN[2], N0[8], N0[9], N0[10], N0[11]); PIN(N0); PIN(N1); PIN(PN); SBAR(); \
  } while (0)

    if (kw) { glds16s(dsrc, dvoff, (unsigned)__builtin_amdgcn_readfirstlane(ddst)); glds16s(dsrc + TS, dvoff, (unsigned)__builtin_amdgcn_readfirstlane(ddst + TS)); glds16s(dsrc + 2 * TS, dvoff, (unsigned)__builtin_amdgcn_readfirstlane(ddst + 2 * TS)); }
    else { glds16s(dsrc, dvoff, (unsigned)__builtin_amdgcn_readfirstlane(ddst)); glds16s(dsrc + TS, dvoff, (unsigned)__builtin_amdgcn_readfirstlane(ddst + TS)); }
    WB(2);
    FRAG(kf[0], LDS_K); FRAG(kf[1], LDS_K + 2048);
    p0 = MFQK(kf[0]); p1 = MFQK(kf[1]);
#pragma unroll
    for (int r = 0; r < 16; ++r) p0[r] = EX(p0[r]);
#pragma unroll
    for (int r = 0; r < 4; ++r) p1[r] = EX(p1[r]);
#pragma unroll
    for (int w = 0; w < 3; ++w) pfA[w] = pk8(pfA[w], p0[4 * w], p0[4 * w + 1], p0[4 * w + 2], p0[4 * w + 3]);
    WB(0);
    DMA8(0, kw ? 3 : 2);
    FRAG(kf[0], LDS_K + TS); FRAG(kf[1], LDS_K + TS + 2048);
    WB(1);
    for (int t = 1; t <= NT - 4; t += 4) {
        STEP_F8(pb0, pb1, p0, p1, pfB, pfA, t, true, true, true, 2, 0, 0, 3);     WB(1);
        STEP_F8(p0, p1, pb0, pb1, pfA, pfB, t + 1, true, true, true, 3, 1, 1, 0); WB(1);
        STEP_F8(pb0, pb1, p0, p1, pfB, pfA, t + 2, true, true, true, 0, 2, 2, 1); WB(1);
        STEP_F8(p0, p1, pb0, pb1, pfA, pfB, t + 3, true, true, true, 1, 3, 3, 2); WB(1);
    }
    STEP_F8(pb0, pb1, p0, p1, pfB, pfA, NT - 3, false, true, true, 2, 0, 0, 3);   WB(0);
    STEP_F8(p0, p1, pb0, pb1, pfA, pfB, NT - 2, false, false, true, 3, 1, 1, 0);  WB(0);
    STEP_F8(pb0, pb1, p0, p1, pfB, pfA, NT - 1, false, false, false, 0, 2, 2, 1); WB(0);
#pragma unroll
    for (int r = 4; r < 16; ++r) pb1[r] = EX(pb1[r]);
    pfB[3] = pk8(pfB[3], pb0[12], pb0[13], pb0[14], pb0[15]);
#pragma unroll
    for (int w = 0; w < 4; ++w) pfB[4 + w] = pk8(pfB[4 + w], pb1[4 * w], pb1[4 * w + 1], pb1[4 * w + 2], pb1[4 * w + 3]);
    FRAG(vf[0], LDS_V + 3 * TS); FRAG(vf[1], LDS_V + 3 * TS + 2048);
    o[0] = MFPV(pfB, vf[0], o[0]); o[1] = MFPV(pfB, vf[1], o[1]); ls = MFPV(pfB, ones8, ls);
    int lane_e = lane; asm volatile("" : "+v"(lane_e));
    const int r32_e = lane_e & 31, hi_e = lane_e >> 5;
    asm volatile("s_waitcnt lgkmcnt(0)\n\ts_barrier" ::: "memory");
    bf16_t* stg = (bf16_t*)shm + wid * 2048;
#pragma unroll
    for (int r = 0; r < 16; ++r) { const int orow = crow(r, hi_e); const float rl = __builtin_amdgcn_rcpf(ls[r]);
#pragma unroll
        for (int d0 = 0; d0 < 2; ++d0) stg[orow * 64 + d0 * 32 + r32_e] = (bf16_t)(cvtpk_s(o[d0][r] * rl, 0.f) & 0xffffu); }
    asm volatile("s_waitcnt lgkmcnt(0)" ::: "memory");
#pragma unroll
    for (int i = 0; i < 4; ++i) { const int row = i * 8 + (lane_e >> 3), ch = lane_e & 7; const u32x4 v = *(const u32x4*)(stg + row * 64 + ch * 8); *(u32x4*)(U.Ow + (size_t)row * U.OP + ch * 8) = v; }
    asm volatile("s_waitcnt lgkmcnt(0)\n\ts_barrier" ::: "memory");
#undef DMA8
#undef RD16
#undef FRAG
#undef MFQK
#undef MFPV
#undef SBAR
#undef PIN
#undef EX
#undef WB
#undef STEP_F8
}
}
constexpr int NWAVES = 8;
constexpr int LDS_BYTES = 155648;
#define LAS __attribute__((address_space(3)))
typedef unsigned short bf16;
typedef unsigned v4u __attribute__((ext_vector_type(4)));
typedef float f32x4 __attribute__((ext_vector_type(4)));
typedef float f32x2 __attribute__((ext_vector_type(2)));
__device__ __forceinline__ unsigned f2bf(float f) { unsigned u = __builtin_bit_cast(unsigned, f); return (u + 0x7fffu + ((u >> 16) & 1u)) >> 16; }
__device__ __forceinline__ unsigned pk2(float lo, float hi) { return f2bf(lo) | (f2bf(hi) << 16); }
#define LDS_WAIT() asm volatile("s_waitcnt lgkmcnt(0)" ::: "memory")

#define GAS __attribute__((address_space(1)))
typedef GAS unsigned gu32;
#define XB_TMO      128
#define XB_XCNT(j)  (256  + 64 * (j))
#define XB_XSUB(j)  (1280 + 64 * (j))
#define XB_XGEN(j)  (2304 + 64 * (j))
#define XB_TOP      3328
#define XB_TOPGEN   3392
#define XCD_BAR_WORDS 3456
#define XB_SPIN_CAP (1u << 18)

__device__ __forceinline__ unsigned xb_ld(unsigned* p)              { return __hip_atomic_load(p, __ATOMIC_RELAXED, __HIP_MEMORY_SCOPE_AGENT); }
__device__ __forceinline__ unsigned xb_add(unsigned* p, unsigned v) { return __hip_atomic_fetch_add(p, v, __ATOMIC_RELAXED, __HIP_MEMORY_SCOPE_AGENT); }
__device__ __forceinline__ unsigned xb_xcc_id() { return (unsigned)__builtin_amdgcn_s_getreg((3 << 11) | 20) & 0xFu; }
#define XB_SPIN(cond, bar) do { unsigned _sp = 0; while (cond) { __builtin_amdgcn_s_sleep(1); \
    if ((++_sp & 255u) == 0u) { if (xb_ld(&(bar)[XB_TMO])) break; if (_sp > XB_SPIN_CAP) { atomicAdd(&(bar)[XB_TMO], 1u); break; } } } } while (0)

struct XcdBarrier {
    unsigned* bar; unsigned x;
    volatile LAS unsigned* st;
};

__device__ __forceinline__ XcdBarrier xcd_barrier_post(unsigned* bar, volatile LAS unsigned* st) {
    XcdBarrier b; b.bar = bar; b.x = xb_xcc_id(); b.st = st;
    if (threadIdx.x == 0) (void)xb_add(&bar[XB_XCNT(b.x)], 1u);
    return b;
}
__device__ __forceinline__ void xcd_barrier_complete(unsigned* bar, unsigned x, unsigned& nloc, unsigned& nx) {
    const unsigned G = gridDim.x * gridDim.y * gridDim.z;
    unsigned sum, cnt, mine, sp = 0u;
    for (;;) {
        sum = 0u; cnt = 0u; mine = 0u;
#pragma unroll
        for (unsigned j = 0; j < 16; ++j) { const unsigned c = xb_ld(&bar[XB_XCNT(j)]); sum += c; cnt += (c > 0u) ? 1u : 0u; mine = (j == x) ? c : mine; }
        if (sum == G) break;
        __builtin_amdgcn_s_sleep(1);
        if ((++sp & 255u) == 0u) { if (xb_ld(&bar[XB_TMO])) break; if (sp > XB_SPIN_CAP) { atomicAdd(&bar[XB_TMO], 1u); break; } }
    }
    nloc = mine > 0u ? mine : 1u; nx = cnt > 0u ? cnt : 1u;
}

__device__ __forceinline__ void xcd_barrier(const XcdBarrier& b) {
    asm volatile("s_waitcnt vmcnt(0)" ::: "memory");
    __syncthreads();
    if (threadIdx.x == 0) {
        unsigned* bar = b.bar;
        __builtin_amdgcn_s_waitcnt(0);
        unsigned nloc = b.st[0], nx = b.st[1];
        if (nloc == 0u) { xcd_barrier_complete(bar, b.x, nloc, nx); b.st[0] = nloc; b.st[1] = nx; }
        const unsigned old = xb_add(&bar[XB_XSUB(b.x)], 1u);
        const unsigned gen = old / nloc;
        if (old + 1u == (gen + 1u) * nloc) {
            __builtin_amdgcn_fence(__ATOMIC_RELEASE, "agent");
            asm volatile("s_waitcnt vmcnt(0)" ::: "memory");
            const unsigned og = xb_add(&bar[XB_TOP], 1u);
            const unsigned tg = og / nx;
            if (og + 1u == (tg + 1u) * nx) xb_add(&bar[XB_TOPGEN], 1u);
            else XB_SPIN(xb_ld(&bar[XB_TOPGEN]) == tg, bar);
            __builtin_amdgcn_fence(__ATOMIC_ACQUIRE, "agent");
            xb_add(&bar[XB_XGEN(b.x)], 1u);
            asm volatile("s_waitcnt vmcnt(0)" ::: "memory");
        } else {
            XB_SPIN(xb_ld(&bar[XB_XGEN(b.x)]) == gen, bar);
            __builtin_amdgcn_fence(__ATOMIC_ACQUIRE, "agent");
            asm volatile("s_waitcnt vmcnt(0)" ::: "memory");
        }
    }
    __syncthreads();
}

struct Params {
    const float *xp, *xs, *attn_norm, *w_in, *lq1, *lk1, *lq2, *lk2, *subw, *qnw, *knw, *w_out, *ffn_norm, *wq, *keys, *pu, *pv, *finw;
    float* out; unsigned char* ws; int ph_lo, ph_hi;
};

template <bool WIN>
__device__ __forceinline__ void p0_transpose_item(const float* W, int K, int N, bf16* WT, LAS float* scr, int item, int lane) {
    const int nblk = N / 32, kb = item / nblk, nb = item % nblk, k0 = 64 * kb, n0 = 32 * nb;
#pragma unroll 8
    for (int i = 0; i < 32; ++i) { const int kk = 2 * i + (lane >> 5); scr[kk * 33 + (lane & 31)] = W[(size_t)(k0 + kk) * N + n0 + (lane & 31)]; }
    LDS_WAIT(); asm volatile("" ::: "memory");
    const int c = lane & 7;
#pragma unroll
    for (int j = 0; j < 4; ++j) { const int n = (lane >> 3) + 8 * j; const LAS float* s = scr + (8 * c) * 33 + n;
        v4u o; o.x = pk2(s[0 * 33], s[1 * 33]); o.y = pk2(s[2 * 33], s[3 * 33]); o.z = pk2(s[4 * 33], s[5 * 33]); o.w = pk2(s[6 * 33], s[7 * 33]);
        const int rowo = WIN ? pg8::win_slot_of_col(n0 + n) : (n0 + n);
        *(v4u*)(WT + (size_t)rowo * K + k0 + 8 * c) = o; }
    LDS_WAIT(); asm volatile("" ::: "memory");
}
__device__ __forceinline__ void p0_wk_item(const float* wq, const float* keys, const float* fnw, bf16* WKt, LAS float* lds, int item, int tid) {
    const int hc = item >> 4, k0 = (item & 15) * 64;
    LAS float* wqs = lds;
    LAS float* kys = lds + 64 * 128;
    for (int e = tid; e < 64 * 128; e += 512) { const int kk = e >> 7, d = e & 127; wqs[e] = wq[(size_t)(k0 + kk) * 2048 + hc * 128 + d]; }
    for (int e = tid; e < 128 * 128; e += 512) { const int nn = e >> 7, d = e & 127; kys[nn * 129 + d] = keys[(size_t)(hc * 128 + nn) * 128 + d]; }
    __syncthreads();
    const int nn = tid & 127, kq = tid >> 7;
    float acc[16];
#pragma unroll
    for (int i = 0; i < 16; ++i) acc[i] = 0.f;
    for (int d = 0; d < 128; ++d) { const float kv = kys[nn * 129 + d];
#pragma unroll
        for (int i = 0; i < 16; ++i) acc[i] += wqs[(kq * 16 + i) * 128 + d] * kv; }
    bf16* o = WKt + (size_t)(hc * 128 + nn) * D + k0 + kq * 16;
    const float* fw = fnw + k0 + kq * 16;
    v4u w0, w1;
    w0.x = pk2(acc[0] * fw[0], acc[1] * fw[1]); w0.y = pk2(acc[2] * fw[2], acc[3] * fw[3]); w0.z = pk2(acc[4] * fw[4], acc[5] * fw[5]); w0.w = pk2(acc[6] * fw[6], acc[7] * fw[7]);
    w1.x = pk2(acc[8] * fw[8], acc[9] * fw[9]); w1.y = pk2(acc[10] * fw[10], acc[11] * fw[11]); w1.z = pk2(acc[12] * fw[12], acc[13] * fw[13]); w1.w = pk2(acc[14] * fw[14], acc[15] * fw[15]);
    *(v4u*)o = w0; *(v4u*)(o + 8) = w1;
    __syncthreads();
}
__device__ __forceinline__ f32x2 cs_of(float ang) {
    const double rev = (double)ang * 0.15915494309189533577; const float fr = (float)(rev - floor(rev));
    f32x2 r; r.x = __builtin_amdgcn_cosf(fr); r.y = __builtin_amdgcn_sinf(fr); return r;
}
typedef float f32x2c __attribute__((ext_vector_type(2)));
typedef unsigned v6u __attribute__((ext_vector_type(6)));
typedef unsigned v4u __attribute__((ext_vector_type(4)));
typedef unsigned v2u __attribute__((ext_vector_type(2)));
typedef float v32f __attribute__((ext_vector_type(32)));
typedef int i32x4g __attribute__((ext_vector_type(4)));
constexpr int ROWS6 = 192;
constexpr int SLB = NEXP * ROWS6;
constexpr int SLU = NEXP * 128, NSU = 8, NBU = PEER_NBU;
constexpr int PT = 6;
constexpr int NPB = 4, NQ = 16 / NPB, NB = PEER_NB;
static_assert(NQ % NB == 0 && NB >= 2, "ring");
constexpr int PW_REC = 0, PW_ACT = PT * 512, PW_R = 2 * PT * 512, PW_Y = 2 * PT * 512 + 64, PW_BYTES = PW_Y + PT * 2048;
static_assert(NWAVES * PW_BYTES <= LDS_BYTES - 64, "per-wave PEER scratch does not fit");
struct Row6 { v6u d; };
typedef LAS char* pw_ptr;
struct P16x2 { f32x2c p[16]; };
__device__ __forceinline__ P16x2 peer_cvt6(const Row6& r) { return __builtin_bit_cast(P16x2, __builtin_amdgcn_cvt_scalef32_pk32_f32_fp6(r.d, 1.0f)); }
typedef _Float16 h2g __attribute__((ext_vector_type(2)));
struct H16x2 { h2g p[16]; };
__device__ __forceinline__ H16x2 peer_cvt6h(const Row6& r) { return __builtin_bit_cast(H16x2, __builtin_amdgcn_cvt_scalef32_pk32_f16_fp6(r.d, 1.0f)); }
__device__ __forceinline__ void peer_axpy(const Row6& r, h2g w2, h2g (&acc)[16]) {
    const H16x2 v = peer_cvt6h(r);
#pragma unroll
    for (int k = 0; k < 16; ++k) acc[k] = __builtin_elementwise_fma(w2, v.p[k], acc[k]);
}
template <int N> struct RecT;
template <> struct RecT<4> { typedef i32x4g type; };
template <> struct RecT<2> { typedef int type __attribute__((ext_vector_type(2))); };
template <> struct RecT<8> { typedef int type __attribute__((ext_vector_type(8))); };
typedef RecT<NPB>::type recv_t;
#define PB_RECS(rv, t, q) do { rv = *(const LAS recv_t*)(L + PW_REC + (t) * 512 + (g16 + NPB * (q)) * 4); } while (0)
#define PB_LOAD(buf, T6, rv, soff) do { _Pragma("unroll") for (int i_ = 0; i_ < NPB; ++i_) { \
      int oa_, ob_; asm("v_mad_u32_u16 %0, %1, %2, %3" : "=v"(oa_) : "v"(rv[i_]), "s"(128), "v"(lo16)); asm("v_mad_u32_u16 %0, %1, %2, %3" : "=v"(ob_) : "v"(rv[i_]), "s"(64), "v"(hi8));     \
      const v4u lo_ = __builtin_bit_cast(v4u, __builtin_amdgcn_raw_buffer_load_b128(T6, oa_, soff, 0)); const v2u hi_ = __builtin_bit_cast(v2u, __builtin_amdgcn_raw_buffer_load_b64(T6, ob_, soff, 0)); \
      buf[i_].d = (v6u){lo_[0], lo_[1], lo_[2], lo_[3], hi_[0], hi_[1]}; } } while (0)
__device__ __forceinline__ float sum8(float v) { v += dppf<0xB1>(v); v += dppf<0x4E>(v); v += dppf<0x141>(v); return v; }
template <int CTRL> __device__ __forceinline__ int dppi(int v) { return __builtin_amdgcn_update_dpp(0, v, CTRL, 0xF, 0xF, true); }
#define PB_LOADU(buf, T8, rv, soff) do { _Pragma("unroll") for (int i_ = 0; i_ < 4; ++i_) { \
      int oa_; asm("v_mad_u32_u16 %0, %1, %2, %3" : "=v"(oa_) : "v"(rv[i_]), "s"(128), "v"(lo16)); \
      buf[i_] = __builtin_bit_cast(v4u, __builtin_amdgcn_raw_buffer_load_b128(T8, oa_, soff, 0)); } } while (0)
__device__ __forceinline__ int pb_u_part(const v4u (&buf)[4], const v4u& xq, int m) {
    int d[4];
#pragma unroll
    for (int i = 0; i < 4; ++i) { int a = __builtin_amdgcn_sdot4((int)buf[i][0], (int)xq[0], 0, false); a = __builtin_amdgcn_sdot4((int)buf[i][1], (int)xq[1], a, false);
        a = __builtin_amdgcn_sdot4((int)buf[i][2], (int)xq[2], a, false); d[i] = __builtin_amdgcn_sdot4((int)buf[i][3], (int)xq[3], a, false); }
    const bool b2 = (m & 4) != 0, b1 = (m & 2) != 0;
    const int e0 = (b2 ? d[2] : d[0]) + dppi<0x141>(b2 ? d[0] : d[2]), e1 = (b2 ? d[3] : d[1]) + dppi<0x141>(b2 ? d[1] : d[3]);
    const int f0 = (b1 ? e1 : e0) + dppi<0x4E>(b1 ? e0 : e1);
    return f0 + dppi<0xB1>(f0);
}
typedef unsigned wv_t __attribute__((ext_vector_type(NPB)));
template <bool FIRST>
__device__ __forceinline__ void pb_v_part(const Row6 (&buf)[NPB], const wv_t& rv, h2g (&acc)[16]) {
#pragma unroll
    for (int i = 0; i < NPB; ++i) { Row6 rr = buf[i]; const unsigned wu = rv[i]; const h2g w2 = __builtin_bit_cast(h2g, wu);
        if (FIRST && i == 0) {
            const H16x2 v = peer_cvt6h(rr);
#pragma unroll
            for (int k = 0; k < 16; ++k) acc[k] = w2 * v.p[k];
        } else {
            asm volatile("" : "+v"(rr.d) : "v"(acc[0]), "v"(acc[1]), "v"(acc[2]), "v"(acc[3]), "v"(acc[4]), "v"(acc[5]), "v"(acc[6]), "v"(acc[7]), "v"(acc[8]), "v"(acc[9]), "v"(acc[10]), "v"(acc[11]), "v"(acc[12]), "v"(acc[13]), "v"(acc[14]), "v"(acc[15]));
            peer_axpy(rr, w2, acc); }
        __builtin_amdgcn_sched_barrier(0); }
}
__device__ __forceinline__ h2g hswap_add32(h2g a, h2g b) { auto r = __builtin_amdgcn_permlane32_swap(__builtin_bit_cast(unsigned, a), __builtin_bit_cast(unsigned, b), false, false); return __builtin_bit_cast(h2g, (unsigned)r[0]) + __builtin_bit_cast(h2g, (unsigned)r[1]); }
__device__ __forceinline__ h2g hswap_add16(h2g a, h2g b) { auto r = __builtin_amdgcn_permlane16_swap(__builtin_bit_cast(unsigned, a), __builtin_bit_cast(unsigned, b), false, false); return __builtin_bit_cast(h2g, (unsigned)r[0]) + __builtin_bit_cast(h2g, (unsigned)r[1]); }
__device__ __forceinline__ void peer_block(int tok0, float* X1, const unsigned short* X1B, const int* TKI, const float* TKS, __amdgpu_buffer_rsrc_t U8r, __amdgpu_buffer_rsrc_t V6, const float* USC, const float* VSC,
                                           const float* finw, pw_ptr L, int lane) {
    const int g = lane >> 3, m = lane & 7, g16 = 16 * g, lo16 = 16 * m, hi8 = NEXP * 128 + 8 * m;
#pragma unroll
    for (int t = 0; t < PT; ++t) {
        const size_t tk = (size_t)(tok0 + t);
        const size_t rk0 = ((size_t)(lane >> 4) * M + tk) * 16 + (lane & 15), rk1 = rk0 + (size_t)4 * M * 16;
        *(LAS int*)(L + PW_REC + t * 512 + lane * 4) = TKI[rk0]; *(LAS int*)(L + PW_REC + t * 512 + 256 + lane * 4) = TKI[rk1];
        *(LAS int*)(L + PW_ACT + t * 512 + lane * 4) = 0; *(LAS int*)(L + PW_ACT + t * 512 + 256 + lane * 4) = 0;
        const v4u* xb = (const v4u*)(X1B + tk * D + 16 * lane); float ss = 0.f, am = 0.f; float xv[16];
        const v4u xb0 = xb[0], xb1 = xb[1];
#pragma unroll
        for (int q = 0; q < 4; ++q) { const unsigned w0 = (q < 2) ? xb0[2 * (q & 1)] : xb1[2 * (q & 1)], w1 = (q < 2) ? xb0[2 * (q & 1) + 1] : xb1[2 * (q & 1) + 1];
            const f32x4 a = {__uint_as_float(w0 << 16), __uint_as_float(w0 & 0xffff0000u), __uint_as_float(w1 << 16), __uint_as_float(w1 & 0xffff0000u)};
            ss += a[0] * a[0] + a[1] * a[1] + a[2] * a[2] + a[3] * a[3];
            am = fmaxf(am, fmaxf(fmaxf(fabsf(a[0]), fabsf(a[1])), fmaxf(fabsf(a[2]), fabsf(a[3])))); xv[4 * q] = a[0]; xv[4 * q + 1] = a[1]; xv[4 * q + 2] = a[2]; xv[4 * q + 3] = a[3]; }
        am = row16_max(am); am = fmaxf(am, __shfl_xor(am, 16)); am = fmaxf(am, __shfl_xor(am, 32)); am = fmaxf(am, 1e-30f);
        const float qs = 127.0f / am; v4u xq;
#pragma unroll
        for (int q = 0; q < 4; ++q) { unsigned w = 0u;
#pragma unroll
            for (int j = 0; j < 4; ++j) w |= ((unsigned)(int)rintf(xv[4 * q + j] * qs) & 0xffu) << (8 * j);
            xq[q] = w; }
        *(LAS v4u*)(L + PW_Y + t * 1024 + 16 * lane) = xq;
        const float r = 1.0f / sqrtf(wave_sum(ss) * (1.0f / D) + EPS);
        if (lane == 0) { *(LAS float*)(L + PW_R + t * 8) = r; *(LAS float*)(L + PW_R + t * 8 + 4) = r * am * (1.0f / 127.0f); }
    }
    Row6 bb[NB][NPB]; recv_t rv;
    {
        v4u bu[NBU][4]; v4u xq;
#pragma unroll
        for (int q = 0; q < NBU - 1; ++q) { PB_RECS(rv, 0, q); PB_LOADU(bu[q], U8r, rv, 0); }
        for (int it = 0; it < NSU * PT; ++it) {
            const int c = it / PT, t = it - c * PT; const int soff = c * SLU;
            const int itn = it + 1, cn = itn / PT, tn = itn - cn * PT;
            int rq[4];
            xq = *(const LAS v4u*)(L + PW_Y + t * 1024 + 128 * c + 16 * m);
#pragma unroll
            for (int q = 0; q < 4; ++q) {
                const int qa = q + NBU - 1;
                if (qa < 4) { PB_RECS(rv, t, qa); PB_LOADU(bu[qa % NBU], U8r, rv, soff); }
                else if (itn < NSU * PT) { PB_RECS(rv, tn, qa - 4); PB_LOADU(bu[qa % NBU], U8r, rv, cn * SLU); }
                rq[q] = pb_u_part(bu[q % NBU], xq, m);
            }
            LAS int* ap = (LAS int*)(L + PW_ACT + t * 512 + (g16 + 8 * (m & 1) + (m >> 1)) * 4);
            ap[0] += (m & 1) ? rq[2] : rq[0]; ap[4] += (m & 1) ? rq[3] : rq[1];
        }
    }
#pragma unroll
    for (int t = 0; t < PT; ++t) {
        const size_t tk = (size_t)(tok0 + t);
        const float r = *(const LAS float*)(L + PW_R + t * 8), rx = *(const LAS float*)(L + PW_R + t * 8 + 4);
        const int i0 = *(const LAS int*)(L + PW_REC + t * 512 + lane * 4), i1 = *(const LAS int*)(L + PW_REC + t * 512 + 256 + lane * 4);
        const size_t rk0 = ((size_t)(lane >> 4) * M + tk) * 16 + (lane & 15), rk1 = rk0 + (size_t)4 * M * 16;
        const float s0 = TKS[rk0] * r, s1 = TKS[rk1] * r;
        const float e0 = __expf(s0 - row16_max(s0)), e1 = __expf(s1 - row16_max(s1));
        const float g0 = e0 / row16_sum(e0), g1 = e1 / row16_sum(e1);
        const f32x2c sc0 = *(const f32x2c*)(USC + 2 * i0), sc1 = *(const f32x2c*)(USC + 2 * i1);
        const float a0 = (float)*(const LAS int*)(L + PW_ACT + t * 512 + lane * 4) * rx * sc0.x, a1 = (float)*(const LAS int*)(L + PW_ACT + t * 512 + 256 + lane * 4) * rx * sc1.x;
        const float w0 = g0 * 0.5f * a0 * (1.0f + erff(a0 * 0.70710678118654752f)) * sc0.y, w1 = g1 * 0.5f * a1 * (1.0f + erff(a1 * 0.70710678118654752f)) * sc1.y;
        { const h2g h0 = {(_Float16)w0, (_Float16)w0}, h1 = {(_Float16)w1, (_Float16)w1};
          *(LAS unsigned*)(L + PW_ACT + t * 512 + lane * 4) = __builtin_bit_cast(unsigned, h0); *(LAS unsigned*)(L + PW_ACT + t * 512 + 256 + lane * 4) = __builtin_bit_cast(unsigned, h1); }
    }
    {
#pragma unroll
        for (int q = 0; q < NB - 1; ++q) { PB_RECS(rv, 0, q); PB_LOAD(bb[q], V6, rv, 0); }
        const bool up = (lane & 8) != 0;
        for (int it = 0; it < 4 * PT; ++it) {
            const int c = it / PT, t = it - c * PT; const int soff = c * SLB;
            const int itn = it + 1, cn = itn / PT, tn = itn - cn * PT;
            h2g acc[16];
#pragma unroll
            for (int q = 0; q < NQ; ++q) {
                const int qa = q + NB - 1;
                if (qa < NQ) { PB_RECS(rv, t, qa); PB_LOAD(bb[qa % NB], V6, rv, soff); }
                else if (itn < 4 * PT) { PB_RECS(rv, tn, qa - NQ); PB_LOAD(bb[qa % NB], V6, rv, cn * SLB); }
                wv_t rw = *(const LAS wv_t*)(L + PW_ACT + t * 512 + (g16 + NPB * q) * 4); if (q == 0) pb_v_part<true>(bb[q % NB], rw, acc); else pb_v_part<false>(bb[q % NB], rw, acc);
            }
            h2g q8[8], q4[4], o2[2];
#pragma unroll
            for (int k = 0; k < 8; ++k) q8[k] = hswap_add32(acc[k], acc[k + 8]);
#pragma unroll
            for (int j = 0; j < 4; ++j) q4[j] = hswap_add16(q8[j], q8[j + 4]);
#pragma unroll
            for (int i = 0; i < 2; ++i) { const h2g keep = up ? q4[i + 2] : q4[i], send = up ? q4[i] : q4[i + 2];
                o2[i] = keep + __builtin_bit_cast(h2g, (unsigned)__builtin_amdgcn_update_dpp(0, (int)__builtin_bit_cast(unsigned, send), 0x128, 0xF, 0xF, true)); }
            *(LAS v2u*)(L + PW_Y + t * 2048 + (256 * c + 32 * m + 4 * g) * 2) = (v2u){__builtin_bit_cast(unsigned, o2[0]), __builtin_bit_cast(unsigned, o2[1])};
        }
    }
#pragma unroll
    for (int t = 0; t < PT; ++t) {
        float* xr = X1 + (size_t)(tok0 + t) * D + 4 * lane; const unsigned short* xb = X1B + (size_t)(tok0 + t) * D + 4 * lane;
        float x2[16]; float s2 = 0.f;
#pragma unroll
        for (int q = 0; q < 4; ++q) { const v2u xw = *(const v2u*)(xb + 256 * q); const unsigned w0 = xw[0], w1 = xw[1];
            const f32x4 a = {__uint_as_float(w0 << 16), __uint_as_float(w0 & 0xffff0000u), __uint_as_float(w1 << 16), __uint_as_float(w1 & 0xffff0000u)}; const v2u yb = *(const LAS v2u*)(L + PW_Y + t * 2048 + (256 * q + 4 * lane) * 2);
            const unsigned yu0 = yb[0], yu1 = yb[1]; const h2g y0 = __builtin_bit_cast(h2g, yu0), y1 = __builtin_bit_cast(h2g, yu1); const f32x4 y = {(float)y0.x, (float)y0.y, (float)y1.x, (float)y1.y};
            x2[4 * q] = a[0] + y[0]; x2[4 * q + 1] = a[1] + y[1]; x2[4 * q + 2] = a[2] + y[2]; x2[4 * q + 3] = a[3] + y[3];
            s2 += x2[4 * q] * x2[4 * q] + x2[4 * q + 1] * x2[4 * q + 1] + x2[4 * q + 2] * x2[4 * q + 2] + x2[4 * q + 3] * x2[4 * q + 3]; }
        const float r2 = 1.0f / sqrtf(wave_sum(s2) * (1.0f / D) + EPS);
#pragma unroll
        for (int q = 0; q < 4; ++q) { const f32x4 a = *(const f32x4*)(finw + 256 * q + 4 * lane); f32x4 o; o[0] = x2[4 * q] * r2 * a[0]; o[1] = x2[4 * q + 1] * r2 * a[1]; o[2] = x2[4 * q + 2] * r2 * a[2]; o[3] = x2[4 * q + 3] * r2 * a[3]; *(f32x4*)(xr + 256 * q) = o; }
    }
}
__global__ void __launch_bounds__(NWAVES * 64, 2) mk_fwd(Params P) {
    extern __shared__ __attribute__((aligned(16))) unsigned char lds[];
    cg::grid_group grid = cg::this_grid();
    const int tid = threadIdx.x, lane = tid & 63, wave = __builtin_amdgcn_readfirstlane(tid >> 6);
    const int G = gridDim.x, bx = blockIdx.x, vcu = (G % 8 == 0) ? (bx % 8) * (G / 8) + bx / 8 : bx;
    unsigned char* ws = P.ws;
    bf16* WIN_T = (bf16*)(ws + WS_WIN); bf16* WOUT_T = (bf16*)(ws + WS_WOUT); bf16* WK_T = (bf16*)(ws + WS_WK);
    f32x2* ROPEA = (f32x2*)(ws + WS_ROPEA); f32x2* ROPER = (f32x2*)(ws + WS_ROPER); f32x2* ROPEC = (f32x2*)(ws + WS_ROPEC);
    float* CTL = (float*)(ws + WS_CTL);
    unsigned char* U8 = ws + WS_U16; unsigned char* V8 = ws + WS_V16; float* USC = (float*)(ws + WS_V16 + 16 * MiB); float* VSC = USC + NEXP; bf16* XN = (bf16*)(ws + WS_XN); bf16* ACAT = XN;
    bf16* QA = (bf16*)(ws + WS_QA); bf16* KA = (bf16*)(ws + WS_KA); bf16* VA = (bf16*)(ws + WS_VA); bf16* QB = (bf16*)(ws + WS_QB); bf16* KB = (bf16*)(ws + WS_KB); bf16* VB = (bf16*)(ws + WS_VB);
#ifdef GQA_DEBUG_BUILD
    unsigned char* Q8 = (unsigned char*)(ws + WS_TKI); unsigned char* K8 = (unsigned char*)(ws + WS_TKI + 24 * MiB); unsigned char* V8T = (unsigned char*)(ws + WS_TKI + 30 * MiB);
    bf16* DBG = (bf16*)(ws + WS_QA);
#else
    unsigned char* Q8 = (unsigned char*)(ws + WS_QB); unsigned char* K8 = (unsigned char*)(ws + WS_KB); unsigned char* V8T = (unsigned char*)(ws + WS_VB);
#endif
    bf16* X1B = (bf16*)(ws + WS_X1B); int* TKI = (int*)(ws + WS_TKI); float* TKS = (float*)(ws + WS_TKS);
    const int lo = P.ph_lo, hi = P.ph_hi;
    volatile LAS unsigned* xbst = (volatile LAS unsigned*)((LAS unsigned char*)lds + LDS_BYTES - 16);
    if (tid < 2) xbst[tid] = 0u;
    __syncthreads();
    const XcdBarrier bar = xcd_barrier_post((unsigned*)(ws + WS_BAR), xbst);
#define IN(k) (lo <= (k) && (k) < hi)
#define BOTH(k) (IN(k) && IN((k) + 1))
    if (IN(0)) {
        const int gw = vcu * NWAVES + wave, NGW = G * NWAVES, gt = bx * (NWAVES * 64) + tid, NGT = G * NWAVES * 64;
        for (int it = bx; it < 256; it += G) p0_wk_item(P.wq, P.keys, P.ffn_norm, WK_T, (LAS float*)lds, it, tid);
        { LAS float* scr = (LAS float*)(lds + wave * 16384);
          constexpr int I_IN = (D / 64) * (NCOL / 32), I_OUT = (D / 64) * (D / 32);
          for (int it = gw; it < I_IN + I_OUT; it += NGW) {
              if (it < I_IN) p0_transpose_item<true>(P.w_in, D, NCOL, WIN_T, scr, it, lane);
              else p0_transpose_item<false>(P.w_out, D, D, WOUT_T, scr, it - I_IN, lane);
          } }
        for (int rw = gw; rw < 2 * NEXP; rw += NGW) {
            const bool isv = rw >= NEXP; const int row = isv ? rw - NEXP : rw;
            const float* src = (isv ? P.pv : P.pu) + (size_t)row * D + 4 * lane;
            LAS float* stg = (LAS float*)(lds + wave * 16384 + 12288);
#pragma unroll
            for (int q = 0; q < 4; ++q) *(LAS f32x4*)(stg + 256 * q + 4 * lane) = *(const f32x4*)(src + 256 * q);
            float v[16]; float am = 0.f;
#pragma unroll
            for (int q = 0; q < 4; ++q) { f32x4 t = *(const LAS f32x4*)(stg + 16 * lane + 4 * q);
                if (!isv) t = t * *(const f32x4*)(P.ffn_norm + 16 * lane + 4 * q);
                v[4 * q] = t[0]; v[4 * q + 1] = t[1]; v[4 * q + 2] = t[2]; v[4 * q + 3] = t[3];
                am = fmaxf(am, fmaxf(fmaxf(fabsf(t[0]), fabsf(t[1])), fmaxf(fabsf(t[2]), fabsf(t[3])))); }
#pragma unroll
            for (int o = 1; o < 64; o <<= 1) am = fmaxf(am, __shfl_xor(am, o));
            if (!isv) {
                const float a1 = fmaxf(am, 1e-30f), qs = 127.0f / a1; unsigned w4[4];
#pragma unroll
                for (int q = 0; q < 4; ++q) { unsigned w = 0u;
#pragma unroll
                    for (int j = 0; j < 4; ++j) w |= ((unsigned)(int)rintf(v[4 * q + j] * qs) & 0xffu) << (8 * j);
                    w4[q] = w; }
                unsigned* dst = (unsigned*)(U8 + (size_t)(lane >> 3) * NEXP * 128 + (size_t)row * 128 + 16 * (lane & 7));
                dst[0] = w4[0]; dst[1] = w4[1]; dst[2] = w4[2]; dst[3] = w4[3];
                if (lane == 0) USC[2 * row] = a1 * (1.0f / 127.0f);
                continue;
            }
            const float sc = (am > 1e-30f) ? exp2f(floorf(log2f(7.5f / am))) : 1.0f;
            unsigned long long W0 = 0ull; unsigned W1 = 0u;
#pragma unroll
            for (int i = 0; i < 16; ++i) {
                const float y = v[i] * sc, a = fabsf(y);
                float c = (a < 2.0f) ? rintf(a * 8.0f) : ((a < 4.0f) ? 16.0f + rintf((a - 2.0f) * 4.0f) : 24.0f + rintf((a - 4.0f) * 2.0f));
                c = fminf(c, 31.0f);
                const unsigned long long code = (unsigned long long)(((y < 0.f) ? 32u : 0u) | (unsigned)c);
                const int bit = 6 * i;
                if (bit < 64) { W0 |= code << bit; if (bit > 58) W1 |= (unsigned)(code >> (64 - bit)); }
                else W1 |= (unsigned)(code << (bit - 64));
            }
            unsigned char* sl = V8 + (size_t)(lane >> 4) * NEXP * 192;
            unsigned char* sa = sl + (size_t)row * 128; unsigned char* sb = sl + (size_t)NEXP * 128 + (size_t)row * 64;
            const int j8 = (lane >> 1) & 7;
            if ((lane & 1) == 0) { unsigned* dst = (unsigned*)(sa + 16 * j8); dst[0] = (unsigned)W0; dst[1] = (unsigned)(W0 >> 32); dst[2] = W1; }
            else { *(unsigned*)(sa + 16 * j8 + 12) = (unsigned)W0; unsigned* dst = (unsigned*)(sb + 8 * j8); dst[0] = (unsigned)(W0 >> 32); dst[1] = W1; }
            if (lane == 0) USC[2 * row + 1] = 1.0f / sc;
        }
        for (int i = gt; i < SEQ * 32 + 128 * 16 + 64 * 16; i += NGT) {
            if (i < SEQ * 32) { const int t = i >> 5, k = i & 31; const float inv = (float)pow(10000.0, -(double)(2 * k) / 64.0); ROPEA[i] = cs_of((float)t * inv); }
            else { const int j = i - SEQ * 32; const int pos = (j < 2048) ? (j >> 4) : ((j - 2048) >> 4); const int k = j & 15;
                   const float inv = (float)pow(10000.0, -(double)(2 * k) / 32.0); const f32x2 v = cs_of((float)pos * inv);
                   if (j < 2048) ROPER[j] = v; else ROPEC[j - 2048] = v; }
        }
        { f32x4 wn[4];
#pragma unroll
          for (int j = 0; j < 4; ++j) wn[j] = *((const f32x4*)P.attn_norm + lane + 64 * j);
          for (int m0 = gw * 4; m0 < M; m0 += NGW * 4) {
            f32x4 v[4][4];
#pragma unroll
            for (int q = 0; q < 4; ++q) { const f32x4* xr = (const f32x4*)xrow(P.xp, P.xs, m0 + q) + lane;
#pragma unroll
                for (int j = 0; j < 4; ++j) v[q][j] = xr[64 * j]; }
#pragma unroll
            for (int q = 0; q < 4; ++q) { float s = 0.f;
#pragma unroll
                for (int j = 0; j < 4; ++j) s += (v[q][j][0] * v[q][j][0] + v[q][j][1] * v[q][j][1]) + (v[q][j][2] * v[q][j][2] + v[q][j][3] * v[q][j][3]);
                const float rstd = 1.0f / sqrtf(wave_sum(s) * (1.0f / D) + EPS);
                unsigned long long* o8 = (unsigned long long*)(XN + (size_t)(m0 + q) * D) + lane;
#pragma unroll
                for (int j = 0; j < 4; ++j) o8[64 * j] = (unsigned long long)pk2(v[q][j][0] * rstd * wn[j][0], v[q][j][1] * rstd * wn[j][1]) | ((unsigned long long)pk2(v[q][j][2] * rstd * wn[j][2], v[q][j][3] * rstd * wn[j][3]) << 32); }
          } }
        if (bx == 0 && tid < 128) CTL[tid] = 0.f;
        if (bx == 0 && wave == 2) { float a = P.lq1[lane] * P.lk1[lane], b = P.lq2[lane] * P.lk2[lane]; a = wave_sum(a); b = wave_sum(b); if (lane == 0) CTL[128] = expf(a) - expf(b) + LAMBDA_INIT; }
        if (BOTH(0)) grid.sync();
    }
    if (IN(1)) {
        pg8::Gemm g{XN, WIN_T, M, NCOL, D}; pg8::StaticOrder S; S.init(M, NCOL, G, bx);
        pg8::EpiProj E{QA, KA, VA, QB, KB, VB, (const pg8::f32x2g*)ROPEA, (const pg8::f32x2g*)ROPER, (const pg8::f32x2g*)ROPEC, P.qnw, P.knw, Q8, K8, V8T};
        pg8::gemm_phase<pg8::EpiProj, pg8::StaticOrder, true, true>((LAS unsigned char*)lds, g, S, E);
        if (BOTH(1)) xcd_barrier(bar);
    }
    if (IN(2)) {
        const float lam = CTL[128];
        if (wave >= 4) __builtin_amdgcn_s_setprio(1);
        for (int w0 = vcu; w0 < 12 * 256; w0 += G) {
            const int i0 = w0 >> 8, i = (((i0 ^ w0) & 1) ? 6 : 0) + (i0 >> 1), w = (i << 8) | (w0 & 255);
            const int xcd = (w & 255) >> 5, j = w & 31;
            attn::UnitDesc U;
            if (i < 6) {
                const int pair = 3 * xcd + (i >> 1), seq = pair >> 2, ha = pair & 3, qb = j + 32 * (i & 1);
                const int map = wave >> 2; const size_t r0 = (size_t)seq * SEQ;
                U.Qw = QA + (r0 + qb * 128 + (wave & 3) * 32) * 512 + ha * 128 + map * 64;
                U.Kt = KA + r0 * 512 + ha * 128; U.KP = 512; U.Vt = VA + r0 * 512 + ha * 128; U.VP = 512;
                U.Ow = ACAT + (r0 + qb * 128 + (wave & 3) * 32) * D + ha * 128;
                attn::attn_unit_d16(U, (char*)lds, lam, P.subw);
            } else {
                const int k = i - 6; int pair, un;
                if (k < 4) { pair = xcd; un = j * 4 + k; } else { pair = 8 + (xcd >> 1); un = (xcd & 1) * 64 + j * 2 + (k - 4); }
                const int seq = pair >> 1, kvh = pair & 1, hq = kvh * 4 + (un >> 5), qb = un & 31; const size_t r0 = (size_t)seq * SEQ;
#ifdef GQA_DEBUG_BUILD
                U.Qw = QB + (r0 + qb * 256 + wave * 32) * 512 + hq * 64;
                U.Kt = KB + r0 * 128 + kvh * 64; U.KP = 128; U.Vt = VB + r0 * 128 + kvh * 64; U.VP = 128;
                U.Ow = ACAT + (r0 + qb * 256 + wave * 32) * D + 512 + hq * 64;
                attn::attn_unit<64>(U, (char*)lds, lam, P.subw);
#else
                attn::UnitDesc8 Ud;
                Ud.Qw = Q8 + ((size_t)hq * M + r0 + qb * 256 + wave * 32) * 64;
                Ud.Kt = K8 + ((size_t)kvh * M + r0) * 64; Ud.Vt = V8T + ((size_t)kvh * (M / 64) + (r0 >> 6)) * 4096;
                Ud.Ow = ACAT + (r0 + qb * 256 + wave * 32) * D + 512 + hq * 64; Ud.OP = D;
                attn::attn_unit_f8(Ud, (char*)lds);
#endif
            }
        }
#ifdef GQA_DEBUG_BUILD
        xcd_barrier(bar);
        for (int w = vcu; w < 12 * 256; w += G) {
            const int i = w >> 8, xcd = (w & 255) >> 5, j = w & 31;
            if (i < 6) continue;
            const int k = i - 6; int pair, un;
            if (k < 4) { pair = xcd; un = j * 4 + k; } else { pair = 8 + (xcd >> 1); un = (xcd & 1) * 64 + j * 2 + (k - 4); }
            const int seq = pair >> 1, kvh = pair & 1, hq = kvh * 4 + (un >> 5), qb = un & 31; const size_t r0 = (size_t)seq * SEQ;
            attn::UnitDesc8 Ud;
            Ud.Qw = Q8 + ((size_t)hq * M + r0 + qb * 256 + wave * 32) * 64;
            Ud.Kt = K8 + ((size_t)kvh * M + r0) * 64; Ud.Vt = V8T + ((size_t)kvh * (M / 64) + (r0 >> 6)) * 4096;
            Ud.Ow = DBG + (r0 + qb * 256 + wave * 32) * 512 + hq * 64; Ud.OP = 512;
            attn::attn_unit_f8(Ud, (char*)lds);
        }
        xcd_barrier(bar);
        for (size_t e = (size_t)bx * 512 + tid; e < (size_t)M * 512; e += (size_t)G * 512) {
            const size_t row = e >> 9; const int c = (int)(e & 511);
            const float a = __uint_as_float((unsigned)ACAT[row * D + 512 + c] << 16), b = __uint_as_float((unsigned)DBG[row * 512 + c] << 16);
            ACAT[row * D + 512 + c] = (bf16)(attn::cvtpk_s(a + 10.0f * (b - a), 0.f) & 0xffffu);
        }
#endif
        __builtin_amdgcn_s_setprio(0);
        if (BOTH(2)) xcd_barrier(bar);
    }
    if (IN(3)) {
        pg8::Gemm g{ACAT, WOUT_T, M, D, D}; pg8::StaticOrder S; S.init(M, D, G, bx);
        pg8::EpiResid E{P.xp, P.xs, P.out, X1B};
        pg8::gemm_phase<pg8::EpiResid, pg8::StaticOrder, true, true>((LAS unsigned char*)lds, g, S, E);
        if (BOTH(3)) xcd_barrier(bar);
    }
    if (IN(4)) {
        pg8::Gemm g{X1B, WK_T, M, 2048, D}; pg8::StaticOrder S; S.init(M, 2048, G, bx);
        pg8::EpiTopK E{TKI, TKS};
        for (int i = 0;; ++i) { pg8::Unit u; if (!S.next(i, u)) break; pg8::OneUnit O{u};
            pg8::gemm_phase<pg8::EpiTopK, pg8::OneUnit, false, true>((LAS unsigned char*)lds, g, O, E); }
        if (BOTH(4)) xcd_barrier(bar);
    }
    if (IN(5)) {
        const int gw = vcu * NWAVES + wave, NGW = G * NWAVES;
        const unsigned long long ub_ = (unsigned long long)(uintptr_t)U8, vb_ = (unsigned long long)(uintptr_t)V8;
        const unsigned long long ubu_ = ((unsigned long long)(unsigned)__builtin_amdgcn_readfirstlane((int)(ub_ >> 32)) << 32) | (unsigned)__builtin_amdgcn_readfirstlane((int)ub_);
        const unsigned long long vbu_ = ((unsigned long long)(unsigned)__builtin_amdgcn_readfirstlane((int)(vb_ >> 32)) << 32) | (unsigned)__builtin_amdgcn_readfirstlane((int)vb_);
        const __amdgpu_buffer_rsrc_t U6r = __builtin_amdgcn_make_buffer_rsrc((void*)(uintptr_t)ubu_, 0, NEXP * 1024, 0x00020000), V6r = __builtin_amdgcn_make_buffer_rsrc((void*)(uintptr_t)vbu_, 0, NEXP * 768, 0x00020000);
        pw_ptr L = (pw_ptr)((LAS char*)lds + wave * PW_BYTES);
        for (int tok0 = gw * PT; tok0 < M; tok0 += NGW * PT) peer_block(tok0, P.out, X1B, TKI, TKS, U6r, V6r, USC, VSC, P.finw, L, lane);
    }
#undef IN
#undef BOTH
}
static int mk_grid() {
    static int grid = 0;
    if (grid == 0) {
        int dev = 0, cus = 0, per_cu = 0;
        if (hipGetDevice(&dev) != hipSuccess || hipDeviceGetAttribute(&cus, hipDeviceAttributeMultiprocessorCount, dev) != hipSuccess) { grid = -1; return grid; }
        if (hipFuncSetAttribute((const void*)mk_fwd, hipFuncAttributeMaxDynamicSharedMemorySize, LDS_BYTES) != hipSuccess) { fprintf(stderr, "hipFuncSetAttribute failed\n"); grid = -1; return grid; }
        if (hipOccupancyMaxActiveBlocksPerMultiprocessor(&per_cu, (const void*)mk_fwd, NWAVES * 64, LDS_BYTES) != hipSuccess || per_cu < 1) { fprintf(stderr, "occupancy query: %d\n", per_cu); per_cu = 1; }
        (void)hipGetLastError();
        grid = cus;
    }
    return grid;
}
static void mk_launch(Params& p, int lo, int hi, hipStream_t stream) {
    const int grid = mk_grid(); if (grid <= 0) return;
    p.ph_lo = lo; p.ph_hi = hi;
    void* args[] = {&p};
    hipError_t e = hipLaunchCooperativeKernel((const void*)mk_fwd, dim3(grid), dim3(NWAVES * 64), args, LDS_BYTES, stream);
    if (e != hipSuccess) fprintf(stderr, "cooperative launch failed: %s (grid %d)\n", hipGetErrorString(e), grid);
}
extern "C" void kernel_launch(void* const* d_in, const int* in_sizes, int n_in, void* d_out, int out_size, void* d_ws, size_t ws_size, hipStream_t stream) {
    if (n_in != 18 || ws_size < WS_END) { fprintf(stderr, "kernel_launch: unexpected inputs (n_in %d ws %zu)\n", n_in, ws_size); return; }
    Params p{};
    p.xp = (const float*)d_in[0]; p.xs = (const float*)d_in[1]; p.attn_norm = (const float*)d_in[2]; p.w_in = (const float*)d_in[3];
    p.lq1 = (const float*)d_in[4]; p.lk1 = (const float*)d_in[5]; p.lq2 = (const float*)d_in[6]; p.lk2 = (const float*)d_in[7];
    p.subw = (const float*)d_in[8]; p.qnw = (const float*)d_in[9]; p.knw = (const float*)d_in[10]; p.w_out = (const float*)d_in[11];
    p.ffn_norm = (const float*)d_in[12]; p.wq = (const float*)d_in[13]; p.keys = (const float*)d_in[14]; p.pu = (const float*)d_in[15]; p.pv = (const float*)d_in[16]; p.finw = (const float*)d_in[17];
    p.out = (float*)d_out; p.ws = (unsigned char*)d_ws;
    unsigned char* ws = (unsigned char*)d_ws; float* out = (float*)d_out;
    const float* lam = (const float*)(ws + WS_CTL) + 128;
    if (hipMemsetAsync(ws + WS_BAR, 0, 16384, stream) != hipSuccess) { fprintf(stderr, "memset failed\n"); return; }
    mk_launch(p, 0, 6, stream);
}
```
